# Optimizing an MI355X kernel written in HIP

```python
import math
import jax, jax.numpy as jnp
from jax import lax
import numpy as np

D_MODEL = 1024
BATCH = 8
SEQ = 4096
DEPTH = 4

SGU_WIDTH = 512
SGU_GROUPS = 4
SGU_GROUP_DIM = SGU_WIDTH // SGU_GROUPS
SGU_CHUNK = 128
HY_WIDTH = 512
HY_SHORT_CONV = 3
HY_EMB_DIM = 33
HY_BANDS = (HY_EMB_DIM - 1) // 2
HY_FILTER_HIDDEN = 64
HY_FAST_DECAY_PCT = 0.3
HY_SLOW_DECAY_PCT = 1.5
HY_DECAY_TARGET = 1e-2
HY_FILTER_INIT_SCALE = 0.1
XA_HEADS = 4
XA_HEAD_DIM = 128
XA_WIDTH = XA_HEADS * XA_HEAD_DIM
MEM_LEN = 256
N_BRANCH = 3
BRANCH_WIDTH = 512
IN_COLS = 2 * SGU_WIDTH + 3 * HY_WIDTH + XA_WIDTH + N_BRANCH * D_MODEL
N_EXPERTS = 16
EC_CAPACITY = 2
EXPERT_FF = 1024
NORM_EPS = 1e-6
LN_EPS = 1e-5

kernel_name = 'hybrid_sgu_hyena_memxattn_ecmoe_encoder'


def rms_norm(x, g):
    xf = x.astype(jnp.float32)
    y = xf * lax.rsqrt(jnp.mean(xf * xf, axis=-1, keepdims=True) + NORM_EPS)
    return (y * g.astype(jnp.float32)).astype(x.dtype)


def layer_norm(x, g, b):
    xf = x.astype(jnp.float32)
    mu = jnp.mean(xf, axis=-1, keepdims=True)
    var = jnp.mean(jnp.square(xf - mu), axis=-1, keepdims=True)
    y = (xf - mu) * lax.rsqrt(var + LN_EPS)
    return (y * g.astype(jnp.float32) + b.astype(jnp.float32)).astype(x.dtype)


def spatial_gating(z, ln_g, ln_b, w_s, b_s):
    B, L, _ = z.shape
    u, v = jnp.split(z, 2, axis=-1)
    v = layer_norm(v, ln_g, ln_b)
    v = v.reshape(B, L // SGU_CHUNK, SGU_CHUNK, SGU_GROUPS, SGU_GROUP_DIM)
    v = jnp.einsum('gpq,bnqgc->bnpgc', w_s, v) + b_s.T[:, :, None]
    return u * v.reshape(B, L, SGU_WIDTH)


def hyena_filters(L, w1, b1, w2, b2, w3, b3, w4, freq):
    f32 = jnp.float32
    t = jnp.linspace(0.0, 1.0, L, dtype=f32)[:, None]
    w = 2.0 * math.pi * jnp.arange(L, dtype=f32)[:, None] / L
    f = jnp.linspace(1e-4, HY_BANDS - 1, HY_BANDS, dtype=f32)[None, :]
    z = jnp.concatenate([t, jnp.cos(f * w), -jnp.sin(f * w)], axis=-1)
    fr = freq.astype(f32)
    h = jnp.sin(fr * (z @ w1.astype(f32) + b1.astype(f32)))
    h = jnp.sin(fr * (h @ w2.astype(f32) + b2.astype(f32)))
    h = jnp.sin(fr * (h @ w3.astype(f32) + b3.astype(f32)))
    h = h @ w4.astype(f32)
    max_decay = math.log(HY_DECAY_TARGET) / HY_FAST_DECAY_PCT
    min_decay = math.log(HY_DECAY_TARGET) / HY_SLOW_DECAY_PCT
    deltas = jnp.abs(jnp.linspace(min_decay, max_decay, HY_WIDTH, dtype=f32))
    decay = jnp.exp(-t * deltas)
    h_fwd = h[:, :HY_WIDTH] * decay
    h_bwd = h[:, HY_WIDTH:] * decay
    zero = jnp.zeros((1, HY_WIDTH), f32)
    return jnp.concatenate([h_fwd, zero, h_bwd[:0:-1]], axis=0)


def hyena_branch(p, conv_w, conv_b, filt_k, bias):
    B, L, _ = p.shape
    pad = HY_SHORT_CONV // 2
    pp = jnp.pad(p, ((0, 0), (pad, pad), (0, 0)))
    p = sum(conv_w[k] * pp[:, k:k + L] for k in range(HY_SHORT_CONV)) + conv_b
    x0, x1, v = jnp.split(p, 3, axis=-1)
    u = (x1 * v).astype(jnp.float32)
    n = 2 * L
    uf = jnp.fft.rfft(u, n=n, axis=1)
    kf = jnp.fft.rfft(filt_k, n=n, axis=0)
    y = jnp.fft.irfft(uf * kf[None], n=n, axis=1)[:, :L]
    y = y + u * bias.astype(jnp.float32)
    return x0 * y.astype(p.dtype)


def memory_attention(q, mem_n, w_kv):
    B, L, _ = q.shape
    M = mem_n.shape[1]
    k, v = jnp.split(mem_n @ w_kv, 2, axis=-1)
    q = q.reshape(B, L, XA_HEADS, XA_HEAD_DIM)
    k = k.reshape(B, M, XA_HEADS, XA_HEAD_DIM)
    v = v.reshape(B, M, XA_HEADS, XA_HEAD_DIM)
    s = jnp.einsum('bshd,bmhd->bhsm', q.astype(jnp.float32), k.astype(jnp.float32)) / math.sqrt(XA_HEAD_DIM)
    pr = jax.nn.softmax(s, axis=-1)
    o = jnp.einsum('bhsm,bmhd->bshd', pr.astype(v.dtype), v)
    return o.reshape(B, L, XA_WIDTH)


def expert_choice_moe(h, w_router, w1, w3, w2):
    B, L, D = h.shape
    cap = EC_CAPACITY * L // N_EXPERTS
    aff = jax.nn.softmax((h @ w_router).astype(jnp.float32), axis=-1)
    gates, idx = lax.top_k(jnp.swapaxes(aff, 1, 2), cap)
    xin = jax.vmap(lambda hb, ib: hb[ib])(h, idx)
    hid = jax.nn.silu(jnp.einsum('becd,edf->becf', xin, w1)) * jnp.einsum('becd,edf->becf', xin, w3)
    y = jnp.einsum('becf,efd->becd', hid, w2) * gates[..., None].astype(h.dtype)
    return jax.vmap(lambda yb, ib: jnp.zeros((L, D), yb.dtype).at[ib.reshape(-1)].add(yb.reshape(-1, D)))(y, idx)


def setup_inputs(seed: int = 0) -> dict:
    key = jax.random.key(seed)
    ks = iter(jax.random.split(key, 40))

    def nrm(shape, scale):
        return jax.random.normal(next(ks), shape, jnp.float32) * scale

    D, Ld, H = D_MODEL, DEPTH, HY_FILTER_HIDDEN
    return {
        'x': nrm((BATCH, SEQ, D), 1.0),
        'mem': nrm((BATCH, MEM_LEN, D), 1.0),
        'norm1_g': 1.0 + nrm((Ld, D), 0.02),
        'w_in': nrm((Ld, D, IN_COLS), D ** -0.5),
        'gate_b': nrm((Ld, N_BRANCH * D), 0.02),
        'sgu_ln_g': 1.0 + nrm((Ld, SGU_WIDTH), 0.02),
        'sgu_ln_b': nrm((Ld, SGU_WIDTH), 0.02),
        'sgu_w': nrm((Ld, SGU_GROUPS, SGU_CHUNK, SGU_CHUNK), SGU_CHUNK ** -0.5),
        'sgu_b': 1.0 + nrm((Ld, SGU_GROUPS, SGU_CHUNK), 0.02),
        'hy_conv_w': nrm((Ld, HY_SHORT_CONV, 3 * HY_WIDTH), HY_SHORT_CONV ** -0.5),
        'hy_conv_b': nrm((Ld, 3 * HY_WIDTH), 0.02),
        'hy_f_w1': nrm((Ld, HY_EMB_DIM, H), HY_EMB_DIM ** -0.5),
        'hy_f_b1': nrm((Ld, H), 0.1),
        'hy_f_w2': nrm((Ld, H, H), H ** -0.5),
        'hy_f_b2': nrm((Ld, H), 0.1),
        'hy_f_w3': nrm((Ld, H, H), H ** -0.5),
        'hy_f_b3': nrm((Ld, H), 0.1),
        'hy_f_w4': nrm((Ld, H, 2 * HY_WIDTH), HY_FILTER_INIT_SCALE * H ** -0.5),
        'hy_f_freq': 1.0 + nrm((Ld, H), 0.02),
        'hy_bias': nrm((Ld, HY_WIDTH), 1.0),
        'mem_norm_g': 1.0 + nrm((Ld, D), 0.02),
        'w_kv': nrm((Ld, D, 2 * XA_WIDTH), D ** -0.5),
        'w_branch': nrm((Ld, N_BRANCH, BRANCH_WIDTH, D), BRANCH_WIDTH ** -0.5),
        'w_out': nrm((Ld, D, D), D ** -0.5),
        'norm2_g': 1.0 + nrm((Ld, D), 0.02),
        'w_router': nrm((Ld, D, N_EXPERTS), D ** -0.5),
        'w1': nrm((Ld, N_EXPERTS, D, EXPERT_FF), D ** -0.5),
        'w3': nrm((Ld, N_EXPERTS, D, EXPERT_FF), D ** -0.5),
        'w2': nrm((Ld, N_EXPERTS, EXPERT_FF, D), EXPERT_FF ** -0.5),
        'final_g': 1.0 + nrm((D,), 0.02),
    }


def reference(x, mem, norm1_g, w_in, gate_b, sgu_ln_g, sgu_ln_b, sgu_w, sgu_b,
              hy_conv_w, hy_conv_b, hy_f_w1, hy_f_b1, hy_f_w2, hy_f_b2, hy_f_w3, hy_f_b3,
              hy_f_w4, hy_f_freq, hy_bias, mem_norm_g, w_kv, w_branch, w_out,
              norm2_g, w_router, w1, w3, w2, final_g):
    B, L, D = x.shape
    c0 = 2 * SGU_WIDTH
    c1 = c0 + 3 * HY_WIDTH
    c2 = c1 + XA_WIDTH
    for l in range(DEPTH):
        h = rms_norm(x, norm1_g[l])
        cols = h @ w_in[l]
        a = spatial_gating(jax.nn.gelu(cols[..., :c0], approximate=False),
                           sgu_ln_g[l], sgu_ln_b[l], sgu_w[l], sgu_b[l])
        filt = hyena_filters(L, hy_f_w1[l], hy_f_b1[l], hy_f_w2[l], hy_f_b2[l],
                             hy_f_w3[l], hy_f_b3[l], hy_f_w4[l], hy_f_freq[l])
        hb = hyena_branch(cols[..., c0:c1], hy_conv_w[l], hy_conv_b[l], filt, hy_bias[l])
        c = memory_attention(cols[..., c1:c2], rms_norm(mem, mem_norm_g[l]), w_kv[l])
        gates = jax.nn.sigmoid((cols[..., c2:] + gate_b[l]).astype(jnp.float32))
        gates = gates.astype(x.dtype).reshape(B, L, N_BRANCH, D)
        br = jnp.stack([a, hb, c], axis=2)
        proj = jnp.einsum('bsnc,ncd->bsnd', br, w_branch[l])
        merged = jnp.sum(gates * proj, axis=2)
        x = x + merged @ w_out[l]
        h = rms_norm(x, norm2_g[l])
        x = x + expert_choice_moe(h, w_router[l], w1[l], w3[l], w2[l])
    return rms_norm(x, final_g)
```

```cpp
#include <hip/hip_runtime.h>
#include <cstdio>
#include <cstdint>
namespace pg8 {
#define PG8_LAS __attribute__((address_space(3)))
typedef unsigned short bf16_t;
typedef short bf16x8 __attribute__((ext_vector_type(8)));
typedef float f32x4 __attribute__((ext_vector_type(4)));
typedef unsigned u32x4 __attribute__((ext_vector_type(4)));
constexpr int BM = 256, BK = 64, HALF = 128, HTB = HALF * BK * 2  , STAGE_BYTES = 8 * HTB, NXCD = 8, WGM = 8;

__host__ __device__ __forceinline__ int lds_byte(int r, int c) { const int st = (r >> 4) * 2 + (c >> 5), rr = r & 15, cc = c & 31, ob = rr * 64 + cc * 2; return st * 1024 + (ob ^ (((ob >> 9) & 1) << 5)); }
__host__ __device__ __forceinline__ void stage_rc(int b, int& R, int& C) { const int st = b / 1024, sb = b % 1024, swz = sb ^ (((sb >> 9) & 1) << 5); R = (st >> 1) * 16 + swz / 64; C = (st & 1) * 32 + (swz % 64) / 2; }
__host__ __device__ __forceinline__ int perm32(int rho) { const int n = rho >> 4, i = rho & 15; return 8 * (i >> 2) + 4 * n + (i & 3); }

struct Unit { int pm, pn; };
struct Gemm { const bf16_t* A; const bf16_t* Bt; int M, N, K; };

struct StaticOrder {
    int nM, nN, nwg, G, c;
    __host__ __device__ __forceinline__ void init(int M, int N, int G_, int c_) { nM = M / BM; nN = N / BM; nwg = nM * nN; G = G_; c = c_; }
    __host__ __device__ __forceinline__ bool next(int i, Unit& u) const {
        const long L = (long)i * G + c; if (L >= nwg) return false;
        int wgid = (int)L; { const int q = nwg / NXCD, r = nwg % NXCD, xcd = wgid % NXCD, off = wgid / NXCD; wgid = (xcd < r ? xcd * (q + 1) : r * (q + 1) + (xcd - r) * q) + off; }
        const int nig = WGM * nN, gid = wgid / nig, fm = gid * WGM, gsz = (nM - fm) < WGM ? (nM - fm) : WGM;
        u.pm = fm + ((wgid % nig) % gsz); u.pn = (wgid % nig) / gsz; return true;
    }
    __device__ __forceinline__ void a_ready(const Unit&) const {}
    __device__ __forceinline__ void done(const Unit&) const {}
};
__device__ __forceinline__ unsigned cvt_pk_bf16(float lo, float hi) { unsigned r; asm volatile("v_cvt_pk_bf16_f32 %0, %1, %2" : "=v"(r) : "v"(lo), "v"(hi)); return r; }
typedef float f32x2 __attribute__((ext_vector_type(2)));
__device__ __forceinline__ f32x2 gelu_pk(f32x2 v) {
    const f32x2 av = __builtin_elementwise_abs(v), d = av * 0.2316418882f + 1.0f;
    f32x2 t; t.x = __builtin_amdgcn_rcpf(d.x); t.y = __builtin_amdgcn_rcpf(d.y);
    f32x2 q = t * 0.5307027145f + (-0.7265760135f); q = q * t + 0.7107068705f; q = q * t + (-0.142248368f); q = q * t + 0.127414796f; q = q * t;
    const f32x2 s = (v * v) * (-0.72134752044f);
    f32x2 e; e.x = __builtin_amdgcn_exp2f(s.x); e.y = __builtin_amdgcn_exp2f(s.y);
    const f32x2 m = v * (q * e), r = v - m;
    f32x2 o; o.x = v.x < 0.f ? m.x : r.x; o.y = v.y < 0.f ? m.y : r.y; return o;
}
template <class T, class = void> struct epi_has_prefetch { static constexpr bool value = false; };
template <class T> struct epi_has_prefetch<T, decltype((void)&T::prefetch)> { static constexpr bool value = true; };
template <class T, class = void> struct epi_has_carry { static constexpr bool value = false; };
template <class T> struct epi_has_carry<T, decltype((void)&T::carry)> { static constexpr bool value = true; };
template <class T, class = void> struct epi_npre { static constexpr int value = 8; };
template <class T> struct epi_npre<T, decltype((void)T::NPRE)> { static constexpr int value = T::NPRE; };
template <class Epi, class Sched, bool ALIGN_EPI = false, bool SP2 = false, bool GATHER = false>
__device__ __forceinline__ void gemm_phase(PG8_LAS unsigned char* lds, const Gemm g, const Sched& S, const Epi& E, const int tid, const PG8_LAS unsigned* rowtab = nullptr) {
    static_assert(!GATHER || SP2, "gather staging is written for the SP2 loop only");
    const int wid = __builtin_amdgcn_readfirstlane(tid >> 6), lane = tid & 63, wr = wid >> 2, wc = wid & 3, fr = lane & 15, fq = lane >> 4;
    const int K = g.K, nt = K / BK;
    unsigned voffA[2], voffB[2];
#pragma unroll
    for (int i = 0; i < 2; ++i) { int R, C; stage_rc(tid * 16 + i * 8192, R, C); const int Rb = Epi::PERM ? ((R & ~31) + perm32(R & 31)) : R;
        voffA[i] = (unsigned)(R * K + C) * 2u; voffB[i] = (unsigned)(Rb * K + C) * 2u; }
    const size_t kstep = (size_t)(BK * 2);
    const size_t hstep = (size_t)HALF * K * 2;
    const size_t tstep = 2 * hstep;
    const size_t hstepA = GATHER ? (size_t)0 : hstep, tstepA = GATHER ? (size_t)0 : tstep;
    const unsigned ldsw = (unsigned)wid * 1024u;
    const int aoff = lds_byte(wr * 64 + fr, fq * 8), boff = lds_byte(wc * 32 + fr, fq * 8);
#define PG8_SA(b, h) (((b) * 2 + (h)) * HTB)
#define PG8_SB(b, h) ((4 + (b) * 2 + (h)) * HTB)
#define PG8_STAGE(bufoff, gbase, voff) do { _Pragma("unroll") for (int _i = 0; _i < 2; ++_i) \
        __builtin_amdgcn_global_load_lds((const unsigned*)((const char*)(gbase) + (voff)[_i]), (PG8_LAS unsigned*)(lds + (bufoff) + ldsw + _i * 8192), 16, 0, 0); } while (0)
#define PG8_LDA(dst, b, h) do { _Pragma("unroll") for (int m = 0; m < 4; ++m) _Pragma("unroll") for (int k = 0; k < 2; ++k) dst[m][k] = *(const PG8_LAS bf16x8*)(lds + PG8_SA(b, h) + aoff + m * 2048 + k * 1024); } while (0)
#define PG8_LDB(dst, b, h) do { _Pragma("unroll") for (int n = 0; n < 2; ++n) _Pragma("unroll") for (int k = 0; k < 2; ++k) dst[n][k] = *(const PG8_LAS bf16x8*)(lds + PG8_SB(b, h) + boff + n * 2048 + k * 1024); } while (0)
#define PG8_MMA(ai, bj, At, Bt) do { __builtin_amdgcn_s_setprio(1); _Pragma("unroll") for (int m = 0; m < 4; ++m) _Pragma("unroll") for (int n = 0; n < 2; ++n) _Pragma("unroll") for (int k = 0; k < 2; ++k) \
        acc[ai][bj][m][n] = __builtin_amdgcn_mfma_f32_16x16x32_bf16(Bt[n][k], At[m][k], acc[ai][bj][m][n], 0, 0, 0); __builtin_amdgcn_s_setprio(0); } while (0)
#define PG8_WAIT_V(n) asm volatile("s_waitcnt vmcnt(" #n ")" ::: "memory")
#define PG8_WAIT_L(n) asm volatile("s_waitcnt lgkmcnt(" #n ")" ::: "memory")
#define PG8_BAR __builtin_amdgcn_s_barrier()
#define PG8_SCHED __builtin_amdgcn_sched_barrier(0)
    Unit cur, nxt; int ui = 0;
    constexpr int NPRE = epi_npre<Epi>::value; float pre[NPRE];
#pragma unroll
    for (int k = 0; k < NPRE; ++k) pre[k] = 0.f;
    if (!S.next(0, cur)) return;
    f32x4 acc[2][2][4][2];
#pragma unroll
    for (int a = 0; a < 2; ++a)
#pragma unroll
        for (int b = 0; b < 2; ++b)
#pragma unroll
            for (int m = 0; m < 4; ++m)
#pragma unroll
                for (int n = 0; n < 2; ++n) acc[a][b][m][n] = (f32x4){0.f, 0.f, 0.f, 0.f};
    bf16x8 At[4][2], B0[2][2], B1[2][2];
    const char* cA = (const char*)g.A + (size_t)cur.pm * tstepA; const char* cB = (const char*)g.Bt + (size_t)cur.pn * tstep;
    unsigned vA0[2], vA1[2], nA0[2], nA1[2];
#pragma unroll
    for (int i = 0; i < 2; ++i) { if constexpr (GATHER) { int R, C; stage_rc(tid * 16 + i * 8192, R, C); vA0[i] = rowtab[R] + (unsigned)C * 2u; vA1[i] = rowtab[128 + R] + (unsigned)C * 2u; } else { vA0[i] = voffA[i]; vA1[i] = voffA[i]; }
        nA0[i] = vA0[i]; nA1[i] = vA1[i]; }
    S.a_ready(cur);
    if constexpr (SP2) {
        PG8_STAGE(PG8_SB(0, 0), cB, voffB); PG8_STAGE(PG8_SB(0, 1), cB + hstep, voffB); PG8_STAGE(PG8_SA(0, 0), cA, vA0); PG8_STAGE(PG8_SA(0, 1), cA + hstepA, vA1);
        if (wr == 1) PG8_BAR;
        PG8_WAIT_V(2); PG8_BAR;
        PG8_STAGE(PG8_SB(1, 0), cB + kstep, voffB); PG8_STAGE(PG8_SA(1, 0), cA + kstep, vA0); PG8_STAGE(PG8_SB(1, 1), cB + hstep + kstep, voffB);
        PG8_WAIT_V(6); PG8_BAR;
    } else {
        PG8_STAGE(PG8_SB(0, 0), cB, voffB); PG8_STAGE(PG8_SA(0, 0), cA, voffA); PG8_STAGE(PG8_SB(0, 1), cB + hstep, voffB); PG8_STAGE(PG8_SA(0, 1), cA + hstep, voffA);
        if (wr == 1) PG8_BAR;
        PG8_WAIT_V(4); PG8_BAR;
        PG8_STAGE(PG8_SB(1, 0), cB + kstep, voffB); PG8_STAGE(PG8_SA(1, 0), cA + kstep, voffA); PG8_STAGE(PG8_SB(1, 1), cB + hstep + kstep, voffB);
        PG8_WAIT_V(6); PG8_BAR;
    }
    for (;;) {
        const bool has_next = S.next(ui + 1, nxt);
        const char* nA = has_next ? (const char*)g.A + (size_t)nxt.pm * tstepA : cA; const char* nB = has_next ? (const char*)g.Bt + (size_t)nxt.pn * tstep : cB;
        for (int t = 0; t < nt; t += 2) {
            const bool last = (t == nt - 2);
            const char* a1 = cA + (size_t)(t + 1) * kstep;
            const char* a2 = last ? nA : cA + (size_t)(t + 2) * kstep; const char* b2 = last ? nB : cB + (size_t)(t + 2) * kstep;
            const char* a3 = a2 + kstep; const char* b3 = b2 + kstep;
            if (last && has_next) S.a_ready(nxt);
            if constexpr (epi_has_prefetch<Epi>::value) { if (last) E.prefetch(cur, wr, wc, fr, fq, pre); }
            if constexpr (GATHER) { if (last && has_next) {
#pragma unroll
                for (int i = 0; i < 2; ++i) { int R, C; stage_rc(tid * 16 + i * 8192, R, C); nA0[i] = rowtab[(ui + 1) * 256 + R] + (unsigned)C * 2u; nA1[i] = rowtab[(ui + 1) * 256 + 128 + R] + (unsigned)C * 2u; } } }
            unsigned wA0[2], wA1[2];
#pragma unroll
            for (int i = 0; i < 2; ++i) { wA0[i] = (GATHER && last) ? nA0[i] : vA0[i]; wA1[i] = (GATHER && last) ? nA1[i] : vA1[i]; }
            if constexpr (SP2) {
            PG8_LDB(B0, 0, 0); PG8_LDB(B1, 0, 1); PG8_SCHED; PG8_LDA(At, 0, 0); PG8_STAGE(PG8_SA(1, 1), a1 + hstepA, vA1);
            PG8_WAIT_V(8); PG8_WAIT_L(0); PG8_BAR; PG8_MMA(0, 0, At, B0); PG8_MMA(0, 1, At, B1); PG8_BAR; PG8_SCHED;
            PG8_LDA(At, 0, 1); PG8_STAGE(PG8_SB(0, 0), b2, voffB); PG8_STAGE(PG8_SB(0, 1), b2 + hstep, voffB); PG8_STAGE(PG8_SA(0, 0), a2, wA0);
            PG8_WAIT_V(8); PG8_WAIT_L(0); PG8_BAR; PG8_MMA(1, 0, At, B0); PG8_MMA(1, 1, At, B1); PG8_BAR; PG8_SCHED;
            PG8_LDB(B0, 1, 0); PG8_LDB(B1, 1, 1); PG8_SCHED; PG8_LDA(At, 1, 0); PG8_STAGE(PG8_SA(0, 1), a2 + hstepA, wA1);
            PG8_WAIT_V(8); PG8_WAIT_L(0); PG8_BAR; PG8_MMA(0, 0, At, B0); PG8_MMA(0, 1, At, B1); PG8_BAR; PG8_SCHED;
            PG8_LDA(At, 1, 1); PG8_STAGE(PG8_SB(1, 0), b3, voffB); PG8_STAGE(PG8_SB(1, 1), b3 + hstep, voffB); PG8_STAGE(PG8_SA(1, 0), a3, wA0);
            PG8_WAIT_V(8); PG8_WAIT_L(0); PG8_BAR; PG8_MMA(1, 0, At, B0); PG8_MMA(1, 1, At, B1); PG8_BAR; PG8_SCHED;
            } else {
            PG8_LDB(B0, 0, 0); PG8_SCHED; PG8_LDA(At, 0, 0); PG8_STAGE(PG8_SA(1, 1), a1 + hstep, voffA);
            PG8_WAIT_L(8); PG8_BAR; PG8_WAIT_L(0); PG8_MMA(0, 0, At, B0); PG8_BAR; PG8_SCHED;
            PG8_LDB(B1, 0, 1); PG8_STAGE(PG8_SB(0, 0), b2, voffB);
            PG8_BAR; PG8_WAIT_L(0); PG8_MMA(0, 1, At, B1); PG8_BAR;
            PG8_LDA(At, 0, 1); PG8_STAGE(PG8_SA(0, 0), a2, voffA);
            PG8_BAR; PG8_WAIT_L(0); PG8_MMA(1, 0, At, B0); PG8_BAR; PG8_SCHED;
            PG8_STAGE(PG8_SB(0, 1), b2 + hstep, voffB);
            PG8_WAIT_V(6); PG8_BAR; PG8_MMA(1, 1, At, B1); PG8_BAR;
            PG8_LDB(B0, 1, 0); PG8_SCHED; PG8_LDA(At, 1, 0); PG8_STAGE(PG8_SA(0, 1), a2 + hstep, voffA);
            PG8_WAIT_L(8); PG8_BAR; PG8_WAIT_L(0); PG8_MMA(0, 0, At, B0); PG8_BAR; PG8_SCHED;
            PG8_LDB(B1, 1, 1); PG8_STAGE(PG8_SB(1, 0), b3, voffB);
            PG8_BAR; PG8_WAIT_L(0); PG8_MMA(0, 1, At, B1); PG8_BAR;
            PG8_LDA(At, 1, 1); PG8_STAGE(PG8_SA(1, 0), a3, voffA);
            PG8_BAR; PG8_WAIT_L(0); PG8_MMA(1, 0, At, B0); PG8_BAR; PG8_SCHED;
            PG8_STAGE(PG8_SB(1, 1), b3 + hstep, voffB);
            PG8_WAIT_V(6); PG8_BAR; PG8_MMA(1, 1, At, B1); PG8_BAR;
            }
        }
        if constexpr (ALIGN_EPI) { if (wr == 0) PG8_BAR; }
        if constexpr (!Epi::AFTER_DRAIN) { if constexpr (epi_has_prefetch<Epi>::value) E(acc, cur, wr, wc, fr, fq, pre); else E(acc, cur, wr, wc, fr, fq); S.done(cur); }
        if (!has_next) break;
        bool keep_acc = false;
        if constexpr (epi_has_carry<Epi>::value) keep_acc = E.carry(cur);
        if (!keep_acc) {
#pragma unroll
        for (int a = 0; a < 2; ++a)
#pragma unroll
            for (int b = 0; b < 2; ++b)
#pragma unroll
                for (int m = 0; m < 4; ++m)
#pragma unroll
                    for (int n = 0; n < 2; ++n) acc[a][b][m][n] = (f32x4){0.f, 0.f, 0.f, 0.f};
        }
        cur = nxt; cA = nA; cB = nB; ++ui;
#pragma unroll
        for (int i = 0; i < 2; ++i) { vA0[i] = nA0[i]; vA1[i] = nA1[i]; }
        if constexpr (ALIGN_EPI) { if (wr == 1) PG8_BAR; }
    }
    PG8_WAIT_V(0);
    if constexpr (!ALIGN_EPI) { if (wr == 0) PG8_BAR; }
    PG8_BAR;
    if constexpr (Epi::AFTER_DRAIN) { E.fused(acc, cur, wr, wc, fr, fq, lds, wid, lane); S.done(cur); }
#undef PG8_SA
#undef PG8_SB
#undef PG8_STAGE
#undef PG8_LDA
#undef PG8_LDB
#undef PG8_MMA
#undef PG8_WAIT_V
#undef PG8_WAIT_L
#undef PG8_BAR
#undef PG8_SCHED
}
}
namespace attn {
typedef unsigned short bf16;
constexpr int   D = 128, NW = 8, QBLK = 32, KVBLK = 64;
constexpr float SCALE = 0.088388347648318440f;
constexpr float THR = 8.f;
constexpr int SDEPTH = 2;
constexpr int LDQ = 512, LDK = 1024, LDO = 512;
constexpr size_t SHM_V = KVBLK * D * 2, SHM_K = KVBLK * D * 2, SHM_ATTN = 2 * SHM_V + 2 * SHM_K + NW * 64 * 4;
using bf16x8 = __attribute__((ext_vector_type(8))) short;
using s16x4  = __attribute__((ext_vector_type(4))) short;
using f32x16 = __attribute__((ext_vector_type(16))) float;
using f32x8  = __attribute__((ext_vector_type(8))) float;
using u32x4  = __attribute__((ext_vector_type(4))) unsigned;
#define KSWZ(row, colB) ((row) * 256 + ((colB) ^ (((row) & 7) << 4)))
#define SBAR() __builtin_amdgcn_sched_barrier(0)
__device__ __forceinline__ int crow(int r, int hi) { return (r & 3) + 8 * (r >> 2) + 4 * hi; }
__device__ __forceinline__ unsigned cvtpk(float lo, float hi) {
  unsigned r; asm volatile("v_cvt_pk_bf16_f32 %0, %1, %2" : "=v"(r) : "v"(lo), "v"(hi)); return r;
}
template <typename TIn> struct Stage;
template <> struct Stage<bf16>  { using T = bf16x8;
  __device__ static __forceinline__ T ld8(const bf16* p) { return *reinterpret_cast<const bf16x8*>(p); }
  __device__ static __forceinline__ bf16x8 tobf(T x) { return x; } };

__device__ __forceinline__ void partialSM(f32x16& p0, f32x16& p1, float& m_reg, float& mn, float& alpha) {
  constexpr float C = SCALE * 1.4426950408889634f;
  float pmax = p0[0]; for (int r = 1; r < 16; ++r) pmax = fmaxf(pmax, p0[r]); for (int r = 0; r < 16; ++r) pmax = fmaxf(pmax, p1[r]);
  { auto rr = __builtin_amdgcn_permlane32_swap(__float_as_uint(pmax), __float_as_uint(pmax), false, false);
    pmax = fmaxf(__uint_as_float(rr[0]), __uint_as_float(rr[1])); }
  if (__builtin_expect(__all(pmax - m_reg <= THR / SCALE), 1)) { mn = m_reg; alpha = 1.f; }
  else { mn = fmaxf(m_reg, pmax); alpha = __builtin_amdgcn_exp2f((m_reg - mn) * C); m_reg = mn; }
  float mnC = -mn * C;
  for (int r = 0; r < 16; ++r) p0[r] = fmaf(p0[r], C, mnC); for (int r = 0; r < 16; ++r) p1[r] = fmaf(p1[r], C, mnC);
  for (int r = 0; r < 16; ++r) p0[r] = __builtin_amdgcn_exp2f(p0[r]);
}
__device__ __forceinline__ void finishSM(f32x16& p0, f32x16& p1, float alpha, float& l_reg, bf16x8& pa0, bf16x8& pa1, bf16x8& pa2, bf16x8& pa3) {
  for (int r = 0; r < 16; ++r) p1[r] = __builtin_amdgcn_exp2f(p1[r]);
  float ps = 0; for (int r = 0; r < 16; ++r) ps += p0[r]; for (int r = 0; r < 16; ++r) ps += p1[r];
  { auto rr = __builtin_amdgcn_permlane32_swap(__float_as_uint(ps), __float_as_uint(ps), false, false);
    ps = __uint_as_float(rr[0]) + __uint_as_float(rr[1]); }
  l_reg = l_reg * alpha + ps;
#define PK4(P, BASE, OUT) do { unsigned a0 = cvtpk(P[BASE + 0], P[BASE + 1]), a1 = cvtpk(P[BASE + 2], P[BASE + 3]);   \
    unsigned b0 = cvtpk(P[BASE + 4], P[BASE + 5]), b1 = cvtpk(P[BASE + 6], P[BASE + 7]);                              \
    auto r0 = __builtin_amdgcn_permlane32_swap(a0, b0, false, false); auto r1 = __builtin_amdgcn_permlane32_swap(a1, b1, false, false); \
    u32x4 w = {r0[0], r1[0], r0[1], r1[1]}; OUT = *reinterpret_cast<bf16x8*>(&w); } while (0)
  PK4(p0, 0, pa0); PK4(p0, 8, pa1); PK4(p1, 0, pa2); PK4(p1, 8, pa3);
#undef PK4
}
__device__ __forceinline__ void qkt(f32x16& p0, f32x16& p1, const bf16* Ks, const bf16x8* qr, int r32, int hi) {
  p0 = f32x16{}; p1 = f32x16{};
  for (int d0 = 0; d0 < 8; ++d0) { int cb = (d0 * 16 + hi * 8) * 2;
    bf16x8 b0 = *reinterpret_cast<const bf16x8*>((const char*)Ks + KSWZ(r32, cb));
    bf16x8 b1 = *reinterpret_cast<const bf16x8*>((const char*)Ks + KSWZ(32 + r32, cb));
    p0 = __builtin_amdgcn_mfma_f32_32x32x16_bf16(b0, qr[d0], p0, 0, 0, 0);
    p1 = __builtin_amdgcn_mfma_f32_32x32x16_bf16(b1, qr[d0], p1, 0, 0, 0); }
}
__device__ __forceinline__ int v_st(int k, int c) { const int kk = (k & ~0xC) | ((k & 4) << 1) | ((k & 8) >> 1); return ((kk >> 3) * 4 + (c >> 5)) * 512 + ((kk & 7) * 32 + (c & 31)) * 2; }
__device__ __forceinline__ int v_rd_base(int lane) { return ((lane & 3) << 3) | (((lane >> 2) & 3) << 6) | (((lane >> 4) & 1) << 5) | (((lane >> 5) & 1) << 8); }
constexpr int v_rd_off(int d0, int ks, int half) { return d0 * 512 + ks * 4096 + half * 2048; }
template <int OFF> __device__ __forceinline__ s16x4 tr_read(int vb) {
  s16x4 r; asm volatile("ds_read_b64_tr_b16 %0, %1 offset:%2" : "=&v"(r) : "v"(vb), "i"(OFF) : "memory"); return r;
}
template <int D0> __device__ __forceinline__ void pv_one(f32x16& od, int vb, bf16x8 pa0, bf16x8 pa1, bf16x8 pa2, bf16x8 pa3) {
  const s16x4 l0 = tr_read<v_rd_off(D0, 0, 0)>(vb), h0 = tr_read<v_rd_off(D0, 0, 1)>(vb), l1 = tr_read<v_rd_off(D0, 1, 0)>(vb), h1 = tr_read<v_rd_off(D0, 1, 1)>(vb);
  const s16x4 l2 = tr_read<v_rd_off(D0, 2, 0)>(vb), h2 = tr_read<v_rd_off(D0, 2, 1)>(vb), l3 = tr_read<v_rd_off(D0, 3, 0)>(vb), h3 = tr_read<v_rd_off(D0, 3, 1)>(vb);
  asm volatile("s_waitcnt lgkmcnt(0)" ::: "memory"); SBAR();
#define PK(L, H) (bf16x8){L[0], L[1], L[2], L[3], H[0], H[1], H[2], H[3]}
  od = __builtin_amdgcn_mfma_f32_32x32x16_bf16(pa0, PK(l0, h0), od, 0, 0, 0);
  od = __builtin_amdgcn_mfma_f32_32x32x16_bf16(pa1, PK(l1, h1), od, 0, 0, 0);
  od = __builtin_amdgcn_mfma_f32_32x32x16_bf16(pa2, PK(l2, h2), od, 0, 0, 0);
  od = __builtin_amdgcn_mfma_f32_32x32x16_bf16(pa3, PK(l3, h3), od, 0, 0, 0);
#undef PK
}
__device__ __forceinline__ void pv_d0(f32x16* o, int vb, bf16x8 pa0, bf16x8 pa1, bf16x8 pa2, bf16x8 pa3) {
  pv_one<0>(o[0], vb, pa0, pa1, pa2, pa3); pv_one<1>(o[1], vb, pa0, pa1, pa2, pa3); pv_one<2>(o[2], vb, pa0, pa1, pa2, pa3); pv_one<3>(o[3], vb, pa0, pa1, pa2, pa3);
}

template <int D0> __device__ __forceinline__ void pv_one_t(f32x16& od, int vb, bf16x8 pa0, bf16x8 pa1, bf16x8 pa2, bf16x8 pa3) {
  const s16x4 l0 = tr_read<v_rd_off(D0, 0, 0)>(vb), h0 = tr_read<v_rd_off(D0, 0, 1)>(vb), l1 = tr_read<v_rd_off(D0, 1, 0)>(vb), h1 = tr_read<v_rd_off(D0, 1, 1)>(vb);
  const s16x4 l2 = tr_read<v_rd_off(D0, 2, 0)>(vb), h2 = tr_read<v_rd_off(D0, 2, 1)>(vb), l3 = tr_read<v_rd_off(D0, 3, 0)>(vb), h3 = tr_read<v_rd_off(D0, 3, 1)>(vb);
  asm volatile("s_waitcnt lgkmcnt(0)" ::: "memory"); SBAR();
#define PK(L, H) (bf16x8){L[0], L[1], L[2], L[3], H[0], H[1], H[2], H[3]}
  od = __builtin_amdgcn_mfma_f32_32x32x16_bf16(PK(l0, h0), pa0, od, 0, 0, 0);
  od = __builtin_amdgcn_mfma_f32_32x32x16_bf16(PK(l1, h1), pa1, od, 0, 0, 0);
  od = __builtin_amdgcn_mfma_f32_32x32x16_bf16(PK(l2, h2), pa2, od, 0, 0, 0);
  od = __builtin_amdgcn_mfma_f32_32x32x16_bf16(PK(l3, h3), pa3, od, 0, 0, 0);
#undef PK
}
__device__ __forceinline__ void pv_d0_t(f32x16* o, int vb, bf16x8 pa0, bf16x8 pa1, bf16x8 pa2, bf16x8 pa3) {
  pv_one_t<0>(o[0], vb, pa0, pa1, pa2, pa3); pv_one_t<1>(o[1], vb, pa0, pa1, pa2, pa3); pv_one_t<2>(o[2], vb, pa0, pa1, pa2, pa3); pv_one_t<3>(o[3], vb, pa0, pa1, pa2, pa3);
}

template <typename TQ>
__device__ __forceinline__ void attn_dense_body(const TQ* __restrict__ Qb, const bf16* __restrict__ Kh, const bf16* __restrict__ Vh,
                                                bf16* __restrict__ Ob, int seq, char* lds, const int tid) {
  using St = Stage<bf16>; using SQ = Stage<TQ>;
  const int wid = tid >> 6, lane = tid & 63, r32 = lane & 31, hi = lane >> 5;
  bf16* V_lds = (bf16*)lds; bf16* K_lds = (bf16*)(lds + 2 * SHM_V);
  float* ws = (float*)(lds + 2 * SHM_V + 2 * SHM_K) + wid * 64; float* li_l = ws; float* al_l = ws + 32;
  float m_reg = -1e30f, l_reg = 0; f32x16 o[4] = {}; bf16x8 qr[8];
  const TQ* Qw = Qb + (long)(wid * QBLK + r32) * LDQ + hi * 8;
#pragma unroll
  for (int d0 = 0; d0 < 8; ++d0) qr[d0] = SQ::tobf(SQ::ld8(Qw + d0 * 16));
  const int sr = tid >> 4, sc = (tid & 15) * 8, vst0 = v_st(sr, sc), vst1 = v_st(32 + sr, sc);
  const int vb0 = (int)(uintptr_t)V_lds + v_rd_base(lane);
  struct { typename St::T vs0, vs1, ks0, ks1; } sr_[SDEPTH];
#define SLOAD(i, k0) do { sr_[i].vs0 = St::ld8(&Vh[(long)((k0) + sr) * LDK + sc]); sr_[i].vs1 = St::ld8(&Vh[(long)((k0) + 32 + sr) * LDK + sc]); \
    sr_[i].ks0 = St::ld8(&Kh[(long)((k0) + sr) * LDK + sc]); sr_[i].ks1 = St::ld8(&Kh[(long)((k0) + 32 + sr) * LDK + sc]); } while (0)
#define SWRITE(b, i) do { *(bf16x8*)((char*)V_lds + (b) * SHM_V + vst0) = St::tobf(sr_[i].vs0);          \
    *(bf16x8*)((char*)V_lds + (b) * SHM_V + vst1) = St::tobf(sr_[i].vs1); int kc = sc * 2;               \
    *(bf16x8*)((char*)K_lds + (b) * SHM_K + KSWZ(sr, kc)) = St::tobf(sr_[i].ks0);                       \
    *(bf16x8*)((char*)K_lds + (b) * SHM_K + KSWZ(32 + sr, kc)) = St::tobf(sr_[i].ks1); } while (0)
#define SWAIT() do { if constexpr (SDEPTH == 2) asm volatile("s_waitcnt vmcnt(4)" ::: "memory"); else asm volatile("s_waitcnt vmcnt(0)" ::: "memory"); } while (0)
#define RESC(a) do { if (__any((a) < 1.f)) { if (hi == 0) al_l[r32] = (a); asm volatile("s_waitcnt lgkmcnt(0)" ::: "memory"); \
    for (int d = 0; d < 4; ++d) for (int r = 0; r < 16; ++r) o[d][r] *= al_l[crow(r, hi)]; } } while (0)
  f32x16 pA0, pA1, pB0, pB1; float mnA, mnB, alA, alB; bf16x8 pa0, pa1, pa2, pa3; const int NT = seq / KVBLK;
  constexpr int SE = 0, SO = SDEPTH - 1;
  SLOAD(SE, 0); asm volatile("s_waitcnt vmcnt(0)" ::: "memory"); SWRITE(0, SE); __syncthreads();
  qkt(pA0, pA1, K_lds, qr, r32, hi); partialSM(pA0, pA1, m_reg, mnA, alA);
  SLOAD(SO, KVBLK); if constexpr (SDEPTH == 2) { if (2 < NT) SLOAD(SE, 2 * KVBLK); }
  SWAIT(); SWRITE(1, SO); __syncthreads();
  for (int j = 1; j + 1 < NT; j += 2) {
    SBAR(); qkt(pB0, pB1, (bf16*)((char*)K_lds + SHM_K), qr, r32, hi);
    finishSM(pA0, pA1, alA, l_reg, pa0, pa1, pa2, pa3); SBAR();
    SLOAD(SO, (j + SDEPTH) * KVBLK); SBAR();
    pv_d0(o, vb0, pa0, pa1, pa2, pa3); partialSM(pB0, pB1, m_reg, mnB, alB);
    __syncthreads(); SWAIT(); SWRITE(0, SE);
    RESC(alB); __syncthreads();
    SBAR(); qkt(pA0, pA1, K_lds, qr, r32, hi);
    finishSM(pB0, pB1, alB, l_reg, pa0, pa1, pa2, pa3); SBAR();
    if (SDEPTH == 1 || j + 3 < NT) SLOAD(SE, (j + 1 + SDEPTH) * KVBLK); SBAR();
    pv_d0(o, vb0 + (int)SHM_V, pa0, pa1, pa2, pa3); partialSM(pA0, pA1, m_reg, mnA, alA);
    __syncthreads(); SWAIT(); SWRITE(1, SO);
    RESC(alA); __syncthreads();
  }
  SBAR(); qkt(pB0, pB1, (bf16*)((char*)K_lds + SHM_K), qr, r32, hi);
  finishSM(pA0, pA1, alA, l_reg, pa0, pa1, pa2, pa3); SBAR();
  pv_d0(o, vb0, pa0, pa1, pa2, pa3); partialSM(pB0, pB1, m_reg, mnB, alB);
  __syncthreads(); RESC(alB);
  finishSM(pB0, pB1, alB, l_reg, pa0, pa1, pa2, pa3); SBAR();
  pv_d0(o, vb0 + (int)SHM_V, pa0, pa1, pa2, pa3);
  if (hi == 0) li_l[r32] = l_reg; asm volatile("s_waitcnt lgkmcnt(0)" ::: "memory");
  float rli[16];
#pragma unroll
  for (int r = 0; r < 16; ++r) rli[r] = __builtin_amdgcn_rcpf(li_l[crow(r, hi)]);
  bf16* Ow = Ob + (long)(wid * QBLK) * LDO;
#pragma unroll
  for (int r = 0; r < 16; ++r) { int orow = crow(r, hi);
    for (int d0 = 0; d0 < 4; ++d0) Ow[(long)orow * LDO + d0 * 32 + r32] = (bf16)(cvtpk(o[d0][r] * rli[r], 0.f) & 0xffffu); }
#undef SLOAD
#undef SWRITE
#undef SWAIT
#undef RESC
}

template <int NQB>
__device__ __forceinline__ void attn_resident(const bf16* __restrict__ Qb, const bf16* __restrict__ Kh, const bf16* __restrict__ Vh, bf16* __restrict__ Ob, char* lds, const int tid) {
  using St = Stage<bf16>;
  const int wid = tid >> 6, lane = tid & 63, r32 = lane & 31, hi = lane >> 5;
  bf16* V_lds = (bf16*)lds; bf16* K_lds = (bf16*)(lds + 4 * SHM_V);
  float* ws = (float*)(lds + 4 * SHM_V + 4 * SHM_K) + wid * 64; float* li_l = ws; float* al_l = ws + 32;
  { const int sr = tid >> 4, sc = (tid & 15) * 8, vst0 = v_st(sr, sc), vst1 = v_st(32 + sr, sc), kc = sc * 2;
    bf16x8 kv[4][4];
#pragma unroll
    for (int j = 0; j < 4; ++j) { kv[j][0] = St::ld8(&Vh[(long)(64 * j + sr) * LDK + sc]); kv[j][1] = St::ld8(&Vh[(long)(64 * j + 32 + sr) * LDK + sc]);
      kv[j][2] = St::ld8(&Kh[(long)(64 * j + sr) * LDK + sc]); kv[j][3] = St::ld8(&Kh[(long)(64 * j + 32 + sr) * LDK + sc]); }
#pragma unroll
    for (int j = 0; j < 4; ++j) { *(bf16x8*)((char*)V_lds + j * SHM_V + vst0) = kv[j][0]; *(bf16x8*)((char*)V_lds + j * SHM_V + vst1) = kv[j][1];
      *(bf16x8*)((char*)K_lds + j * SHM_K + KSWZ(sr, kc)) = kv[j][2]; *(bf16x8*)((char*)K_lds + j * SHM_K + KSWZ(32 + sr, kc)) = kv[j][3]; } }
  __syncthreads();
  const int vb0 = (int)(uintptr_t)V_lds + v_rd_base(lane);
#pragma unroll 1
  for (int qb = 0; qb < NQB; ++qb) {
    const bf16* Qw = Qb + (long)(qb * (QBLK * NW) + wid * QBLK + r32) * LDQ + hi * 8;
    bf16x8 qr[8];
#pragma unroll
    for (int d0 = 0; d0 < 8; ++d0) qr[d0] = St::ld8(Qw + d0 * 16);
    float m_reg = -1e30f, l_reg = 0; f32x16 o[4] = {};
#pragma unroll
    for (int j = 0; j < 4; ++j) { f32x16 p0, p1; float mn, al; bf16x8 pa0, pa1, pa2, pa3;
      qkt(p0, p1, (const bf16*)((const char*)K_lds + j * SHM_K), qr, r32, hi); partialSM(p0, p1, m_reg, mn, al);
      if (__any(al < 1.f)) { if (hi == 0) al_l[r32] = al; asm volatile("s_waitcnt lgkmcnt(0)" ::: "memory"); const float ar = al_l[r32];
        for (int d = 0; d < 4; ++d) for (int r = 0; r < 16; ++r) o[d][r] *= ar; }
      finishSM(p0, p1, al, l_reg, pa0, pa1, pa2, pa3); SBAR();
      pv_d0_t(o, vb0 + j * (int)SHM_V, pa0, pa1, pa2, pa3); }
    if (hi == 0) li_l[r32] = l_reg; asm volatile("s_waitcnt lgkmcnt(0)" ::: "memory");
    const float rl = __builtin_amdgcn_rcpf(li_l[r32]);
    bf16* Ow = Ob + (long)(qb * (QBLK * NW) + wid * QBLK + r32) * LDO + 4 * hi;
#pragma unroll
    for (int d0 = 0; d0 < 4; ++d0)
#pragma unroll
      for (int j4 = 0; j4 < 4; ++j4) { unsigned lo = cvtpk(o[d0][4 * j4] * rl, o[d0][4 * j4 + 1] * rl), hi2 = cvtpk(o[d0][4 * j4 + 2] * rl, o[d0][4 * j4 + 3] * rl);
        typedef unsigned u32x2_ __attribute__((ext_vector_type(2))); u32x2_ w2 = {lo, hi2};
        *(__attribute__((address_space(1))) u32x2_*)(Ow + d0 * 32 + 8 * j4) = w2; }
    asm volatile("s_waitcnt lgkmcnt(0)" ::: "memory");
  }
}

}
#ifndef MK_SINGLE
#define MK_SINGLE 1
#endif
constexpr int NWAVES = 8, NTHR = 512;
constexpr int D = 1024, NB = 8, L = 4096, M = NB * L, DEPTH = 4, MEML = 256, MM = NB * MEML;
constexpr int INC = 6144, NE = 16, CAP = 512, FF = 1024, BW = 512;
constexpr int NPH = 12;
constexpr int NSTEP = DEPTH * NPH;

constexpr size_t MiB = 1u << 20;
constexpr size_t WS_CTL = 0, CTL_ZERO_BYTES = 1 * MiB;
constexpr size_t WS_WIN = 1 * MiB, WS_WKV = 13 * MiB, WS_WBR = 15 * MiB, WS_WOUT = 18 * MiB, WS_W13 = 20 * MiB, WS_W2 = 84 * MiB;
constexpr size_t WS_H = 116 * MiB, WS_MEMN = 180 * MiB, WS_KV = 184 * MiB, WS_FILT = 188 * MiB, WS_AFF = 204 * MiB, WS_IDX = 206 * MiB, WS_GATE = 207 * MiB;
constexpr size_t WS_UV = 208 * MiB, WS_P = 272 * MiB, WS_Q = 368 * MiB, WS_G = 400 * MiB, WS_BR = 592 * MiB, WS_MSUM = 688 * MiB, WS_MERGED = 816 * MiB, WS_U = 880 * MiB;
constexpr size_t WS_XIN = WS_UV, WS_HID = WS_G;
constexpr size_t WS_UT = WS_U, WS_YT = WS_U + 32 * MiB;
constexpr size_t WS_RSTD1 = WS_GATE + 256 * 1024, WS_RSTD2 = WS_GATE + 384 * 1024, WS_RSG = WS_GATE + 512 * 1024;
constexpr size_t WS_RMAP = WS_IDX + 256 * 1024;
constexpr size_t WS_WSB = WS_IDX + 512 * 1024;
constexpr size_t WS_INV = 944 * MiB, WS_Y = WS_UV;
constexpr size_t WS_MEMN4 = 946 * MiB, WS_KV4 = 962 * MiB, WS_WKV4 = 978 * MiB;
constexpr size_t WS_PT = WS_P;
constexpr int PTS = M;
constexpr size_t WS_END = 986 * MiB;
constexpr int CW_BAR = 4096;

constexpr int ROWTAB_OFF = 131072;
constexpr int RING_BYTES = 131072, LDS_BYTES = 147456, LDSCTL_OFF = LDS_BYTES - 1024, MISC_OFF = LDSCTL_OFF + 320;

#define GAS __attribute__((address_space(1)))
#define LAS __attribute__((address_space(3)))
typedef unsigned short bf16;
typedef unsigned v4u __attribute__((ext_vector_type(4)));
typedef unsigned v2u __attribute__((ext_vector_type(2)));
typedef float f32x4 __attribute__((ext_vector_type(4)));
typedef float f32x2 __attribute__((ext_vector_type(2)));
#define LDS_WAIT() asm volatile("s_waitcnt lgkmcnt(0)" ::: "memory")
#define VM_WAIT() asm volatile("s_waitcnt vmcnt(0)" ::: "memory")
__device__ __forceinline__ unsigned f2bf(float f) { unsigned u = __builtin_bit_cast(unsigned, f); return (u + 0x7fffu + ((u >> 16) & 1u)) >> 16; }
__device__ __forceinline__ unsigned pk2(float lo, float hi) { return f2bf(lo) | (f2bf(hi) << 16); }
__device__ __forceinline__ float bflo(unsigned w) { return __builtin_bit_cast(float, w << 16); }
__device__ __forceinline__ float bfhi(unsigned w) { return __builtin_bit_cast(float, w & 0xffff0000u); }
__device__ __forceinline__ float bf2f(bf16 b) { return __builtin_bit_cast(float, ((unsigned)b) << 16); }
__device__ __forceinline__ float wave_sum(float v, int lane) {
#pragma unroll
    for (int o = 1; o < 64; o <<= 1) v += __builtin_bit_cast(float, __builtin_amdgcn_ds_bpermute((lane ^ o) << 2, __builtin_bit_cast(int, v)));
    return v;
}
__device__ __forceinline__ float sin_turns(float t) { t -= floorf(t); return __builtin_amdgcn_sinf(t); }
__device__ __forceinline__ float cos_turns(float t) { t -= floorf(t); return __builtin_amdgcn_cosf(t); }
__device__ __forceinline__ float sin_rad(float x) { return sin_turns(x * 0.15915494309189535f); }
__device__ __forceinline__ float sigmoidf_(float v) { return __builtin_amdgcn_rcpf(1.0f + __builtin_amdgcn_exp2f(-1.4426950408889634f * v)); }

#define XB_TMO      128
#define XB_XCNT(j)  (256  + 64 * (j))
#define XB_XSUB(j)  (1280 + 64 * (j))
#define XB_XGEN(j)  (2304 + 64 * (j))
#define XB_TOP      3328
#define XB_TOPGEN   3392
#define XCD_BAR_WORDS 3456
#define XB_SPIN_CAP (1u << 18)

__device__ __forceinline__ unsigned xb_ld(unsigned* p)              { return __hip_atomic_load(p, __ATOMIC_RELAXED, __HIP_MEMORY_SCOPE_AGENT); }
__device__ __forceinline__ unsigned xb_add(unsigned* p, unsigned v) { return __hip_atomic_fetch_add(p, v, __ATOMIC_RELAXED, __HIP_MEMORY_SCOPE_AGENT); }
__device__ __forceinline__ unsigned xb_xcc_id() { return (unsigned)__builtin_amdgcn_s_getreg((3 << 11) | 20) & 0xFu; }
#define XB_SPIN(cond, bar) do { unsigned _sp = 0; while (cond) { __builtin_amdgcn_s_sleep(1); \
    if ((++_sp & 255u) == 0u) { if (xb_ld(&(bar)[XB_TMO])) break; if (_sp > XB_SPIN_CAP) { atomicAdd(&(bar)[XB_TMO], 1u); break; } } } } while (0)

struct XcdBarrier {
    unsigned* bar; unsigned x;
    volatile LAS unsigned* st;
};

__device__ __forceinline__ XcdBarrier xcd_barrier_post(unsigned* bar, volatile LAS unsigned* st) {
    XcdBarrier b; b.bar = bar; b.x = xb_xcc_id(); b.st = st;
    if (threadIdx.x == 0) (void)xb_add(&bar[XB_XCNT(b.x)], 1u);
    return b;
}
__device__ __forceinline__ void xcd_barrier_complete(unsigned* bar, unsigned x, unsigned& nloc, unsigned& nx) {
    const unsigned G = gridDim.x * gridDim.y * gridDim.z;
    unsigned sum, cnt, mine, sp = 0u;
    for (;;) {
        sum = 0u; cnt = 0u; mine = 0u;
#pragma unroll
        for (unsigned j = 0; j < 16; ++j) { const unsigned c = xb_ld(&bar[XB_XCNT(j)]); sum += c; cnt += (c > 0u) ? 1u : 0u; mine = (j == x) ? c : mine; }
        if (sum == G) break;
        __builtin_amdgcn_s_sleep(1);
        if ((++sp & 255u) == 0u) { if (xb_ld(&bar[XB_TMO])) break; if (sp > XB_SPIN_CAP) { atomicAdd(&bar[XB_TMO], 1u); break; } }
    }
    nloc = mine > 0u ? mine : 1u; nx = cnt > 0u ? cnt : 1u;
}

__device__ __forceinline__ void xcd_barrier(const XcdBarrier& b) {
    asm volatile("s_waitcnt vmcnt(0)" ::: "memory");
    __syncthreads();
    if (threadIdx.x == 0) {
        unsigned* bar = b.bar;
        __builtin_amdgcn_s_waitcnt(0);
        unsigned nloc = b.st[0], nx = b.st[1];
        if (nloc == 0u) { xcd_barrier_complete(bar, b.x, nloc, nx); b.st[0] = nloc; b.st[1] = nx; }
        const unsigned old = xb_add(&bar[XB_XSUB(b.x)], 1u);
        const unsigned gen = old / nloc;
        if (old + 1u == (gen + 1u) * nloc) {
            __builtin_amdgcn_fence(__ATOMIC_RELEASE, "agent");
            asm volatile("s_waitcnt vmcnt(0)" ::: "memory");
            const unsigned og = xb_add(&bar[XB_TOP], 1u);
            const unsigned tg = og / nx;
            if (og + 1u == (tg + 1u) * nx) xb_add(&bar[XB_TOPGEN], 1u);
            else XB_SPIN(xb_ld(&bar[XB_TOPGEN]) == tg, bar);
            __builtin_amdgcn_fence(__ATOMIC_ACQUIRE, "agent");
            xb_add(&bar[XB_XGEN(b.x)], 1u);
            asm volatile("s_waitcnt vmcnt(0)" ::: "memory");
        } else {
            XB_SPIN(xb_ld(&bar[XB_XGEN(b.x)]) == gen, bar);
            __builtin_amdgcn_fence(__ATOMIC_ACQUIRE, "agent");
            asm volatile("s_waitcnt vmcnt(0)" ::: "memory");
        }
    }
    __syncthreads();
}

struct Args { const float* in[30]; float* out; unsigned char* ws; int s_lo, s_hi; };
struct Frame {
    LAS unsigned char* lds;
    volatile LAS unsigned* MISC;
    unsigned* ctl;
    int tid, lane, wave, vcu, G, bid;
    float* x;
    unsigned char* ws;
};
#define WSP(T, off) ((T*)(F.ws + (off)))
constexpr int TAB_OFF = LDSCTL_OFF + 512;
__device__ __forceinline__ const float* inp(const Frame& F, int k) {
    const volatile LAS unsigned* t = (const volatile LAS unsigned*)(F.lds + TAB_OFF) + 2 * k;
    const unsigned lo = __builtin_amdgcn_readfirstlane(t[0]), hi = __builtin_amdgcn_readfirstlane(t[1]);
    return (const float*)(GAS const float*)(((unsigned long long)hi << 32) | lo);
}

struct TileAddr { const float* src; int ld_src; bf16* dst; int ldd; int goff; };
__device__ __forceinline__ void tr_load(const TileAddr& t, f32x4 (&v)[16], int lane) {
    const int r0 = lane >> 4, c4 = (lane & 15) * 4;
#pragma unroll
    for (int i = 0; i < 16; ++i) v[i] = *(const f32x4*)(t.src + (size_t)(4 * i + r0) * t.ld_src + c4);
}
__device__ __forceinline__ void tr_store(const TileAddr& t, const f32x4 (&v)[16], LAS float* scr, const LAS float* gl, int lane) {
    const int r0 = lane >> 4, c4 = (lane & 15) * 4;
#pragma unroll
    for (int i = 0; i < 16; ++i) { const int kk = 4 * i + r0; float gk = 1.0f; if (t.goff >= 0) gk = gl[t.goff + kk];
        scr[(c4 + 0) * 65 + kk] = v[i].x * gk; scr[(c4 + 1) * 65 + kk] = v[i].y * gk; scr[(c4 + 2) * 65 + kk] = v[i].z * gk; scr[(c4 + 3) * 65 + kk] = v[i].w * gk; }
    LDS_WAIT(); asm volatile("" ::: "memory");
    const int kc = lane & 7;
#pragma unroll
    for (int p = 0; p < 8; ++p) { const int n = (lane >> 3) + 8 * p; const LAS float* tt = scr + n * 65 + 8 * kc;
        v4u o; o.x = pk2(tt[0], tt[1]); o.y = pk2(tt[2], tt[3]); o.z = pk2(tt[4], tt[5]); o.w = pk2(tt[6], tt[7]);
        *(v4u*)(t.dst + (size_t)n * t.ldd + 8 * kc) = o; }
    LDS_WAIT(); asm volatile("" ::: "memory");
}
__device__ __forceinline__ void rms_row_bf16(const float* xrow, const float* g, bf16* orow, float* copy_to, int lane) {
    const f32x4* xr = (const f32x4*)xrow + lane;
    f32x4 v[4]; float s = 0.f;
    f32x4 gq[4];
#pragma unroll
    for (int j = 0; j < 4; ++j) { v[j] = ((const GAS f32x4*)xr)[64 * j]; gq[j] = ((const GAS f32x4*)g)[lane + 64 * j]; }
    __builtin_amdgcn_sched_barrier(0);
#pragma unroll
    for (int j = 0; j < 4; ++j) s += (v[j].x * v[j].x + v[j].y * v[j].y) + (v[j].z * v[j].z + v[j].w * v[j].w);
    const float rstd = 1.0f / sqrtf(wave_sum(s, lane) * (1.f / 1024.f) + 1e-6f);
    unsigned long long* o8 = (unsigned long long*)orow + lane;
#pragma unroll
    for (int j = 0; j < 4; ++j) { const f32x4 gv = gq[j];
        o8[64 * j] = (unsigned long long)pk2(v[j].x * rstd * gv.x, v[j].y * rstd * gv.y) | ((unsigned long long)pk2(v[j].z * rstd * gv.z, v[j].w * rstd * gv.w) << 32);
        if (copy_to) ((f32x4*)copy_to)[lane + 64 * j] = v[j]; }
}

__device__ __forceinline__ void xb_row_load(const float* xrow, f32x4 (&v)[4], int lane) {
    const GAS f32x4* xr = (const GAS f32x4*)xrow + lane;
#pragma unroll
    for (int j = 0; j < 4; ++j) v[j] = xr[64 * j];
}
__device__ __forceinline__ void xb_row_finish(const f32x4 (&v)[4], bf16* orow, float* rstd_out, int lane) {
    float s = 0.f;
#pragma unroll
    for (int j = 0; j < 4; ++j) s += (v[j].x * v[j].x + v[j].y * v[j].y) + (v[j].z * v[j].z + v[j].w * v[j].w);
    const float rstd = 1.0f / sqrtf(wave_sum(s, lane) * (1.f / 1024.f) + 1e-6f);
    if (lane == 0) *rstd_out = rstd;
    GAS unsigned long long* o8 = (GAS unsigned long long*)orow + lane;
#pragma unroll
    for (int j = 0; j < 4; ++j) o8[64 * j] = (unsigned long long)pk2(v[j].x, v[j].y) | ((unsigned long long)pk2(v[j].z, v[j].w) << 32);
}

__device__ __forceinline__ void ph_prep(Frame& F, const Args& A, int lay) {
    const int gw = F.vcu * NWAVES + F.wave, NGW = F.G * NWAVES, lane = F.lane;
    const int parts = 3, vb = F.bid, vG = F.G;
    {
        const float* w_in = inp(F, 3) + (size_t)lay * D * INC;
        const float* w_kv = inp(F, 21);
        const float* w_br = inp(F, 22) + (size_t)lay * 3 * BW * D;
        const float* w_out = inp(F, 23) + (size_t)lay * D * D;
        const float* w1 = inp(F, 26) + (size_t)lay * NE * D * FF;
        const float* w3 = inp(F, 27) + (size_t)lay * NE * D * FF;
        const float* w2 = inp(F, 28) + (size_t)lay * NE * FF * D;
        bf16* WIN = WSP(bf16, WS_WIN); bf16* WKV = WSP(bf16, WS_WKV4); bf16* WBR = WSP(bf16, WS_WBR); bf16* WOUT = WSP(bf16, WS_WOUT);
        bf16* W13 = WSP(bf16, WS_W13); bf16* W2 = WSP(bf16, WS_W2);
        constexpr int T_IN = 16 * 96, T_BR = 3 * 8 * 16, T_OUT = 16 * 16, T_E = NE * 16 * 16, T_KV = DEPTH * 16 * 16;
        const int NTILES = (parts & 2) ? T_IN + T_BR + T_OUT + 3 * T_E + (lay == 0 ? T_KV : 0) : T_IN + T_BR + T_OUT;
        const int TLO = (parts & 1) ? 0 : T_IN + T_BR + T_OUT;
        LAS float* scr64 = (LAS float*)(F.lds + F.wave * 16640);
        LAS float* gl = (LAS float*)(F.lds + 8 * 16640);
        { const float* g1 = inp(F, 2) + (size_t)lay * D; const float* g2 = inp(F, 24) + (size_t)lay * D;
          __syncthreads();
          { const float a0 = ((const GAS float*)g1)[F.tid], a1 = ((const GAS float*)g1)[F.tid + NTHR], b0 = ((const GAS float*)g2)[F.tid], b1 = ((const GAS float*)g2)[F.tid + NTHR];
            gl[F.tid] = a0; gl[F.tid + NTHR] = a1; gl[D + F.tid] = b0; gl[D + F.tid + NTHR] = b1; }
          __syncthreads(); }
#define TR_DECODE(it_, T_) do { int r = (it_); \
            if (r < T_IN) { const int kb = r / 96, nb = r % 96; T_.src = w_in + (size_t)(64 * kb) * INC + 64 * nb; T_.ld_src = INC; T_.dst = WIN + (size_t)(64 * nb) * 1024 + 64 * kb; T_.ldd = 1024; T_.goff = 64 * kb; break; } r -= T_IN; \
            T_.goff = -1; if (r < T_BR) { const int n = r / 128, r2 = r % 128, kb = r2 / 16, nb = r2 % 16; T_.src = w_br + (size_t)n * BW * D + (size_t)(64 * kb) * D + 64 * nb; T_.ld_src = D; T_.dst = WBR + (size_t)(n * 1024 + 64 * nb) * BW + 64 * kb; T_.ldd = BW; break; } r -= T_BR; \
            if (r < T_OUT) { const int kb = r / 16, nb = r % 16; T_.src = w_out + (size_t)(64 * kb) * D + 64 * nb; T_.ld_src = D; T_.dst = WOUT + (size_t)(64 * nb) * D + 64 * kb; T_.ldd = D; break; } r -= T_OUT; \
            if (r < 2 * T_E) { const int which = r / T_E, r1 = r % T_E, e = r1 / 256, r2 = r1 % 256, kb = r2 / 16, nb = r2 % 16, f0 = 64 * nb; \
                T_.src = (which ? w3 : w1) + (size_t)e * D * FF + (size_t)(64 * kb) * FF + f0; T_.ld_src = FF; \
                T_.dst = W13 + (size_t)(e * 2048 + (f0 >> 7) * 256 + (f0 & 127) + which * 128) * D + 64 * kb; T_.ldd = D; T_.goff = 1024 + 64 * kb; break; } r -= 2 * T_E; \
            if (r < T_E) { const int e = r / 256, r2 = r % 256, kb = r2 / 16, nb = r2 % 16; T_.src = w2 + (size_t)e * FF * D + (size_t)(64 * kb) * D + 64 * nb; T_.ld_src = D; T_.dst = W2 + (size_t)(e * 1024 + 64 * nb) * FF + 64 * kb; T_.ldd = FF; break; } r -= T_E; \
            { const int lk = r / 256, r2 = r % 256, kb = r2 / 16, nb = r2 % 16; T_.src = w_kv + (size_t)lk * D * 1024 + (size_t)(64 * kb) * 1024 + 64 * nb; T_.ld_src = 1024; T_.dst = WKV + (size_t)(lk * 1024 + 64 * nb) * D + 64 * kb; T_.ldd = D; } } while (0)
        int it = TLO + gw; TileAddr tc; f32x4 vc[16];
        if (it < NTILES) { TR_DECODE(it, tc); tr_load(tc, vc, lane); }
        while (it < NTILES) { const int nx = it + NGW; const bool hn = nx < NTILES; TileAddr tn = tc; f32x4 vn[16];
            if (hn) { TR_DECODE(nx, tn); tr_load(tn, vn, lane); }
            tr_store(tc, vc, scr64, gl, lane);
            if (hn) { tc = tn;
#pragma unroll
                for (int i = 0; i < 16; ++i) vc[i] = vn[i]; }
            it = nx; }
#undef TR_DECODE
    }
    if (parts & 1) {
    {
        const float* sw = inp(F, 7) + (size_t)lay * 4 * 128 * 128; bf16* WSB = WSP(bf16, WS_WSB);
        for (int i = vb * NTHR + F.tid; i < 4 * 128 * 128 / 8; i += vG * NTHR) { const f32x4 a = ((const f32x4*)sw)[2 * i], b = ((const f32x4*)sw)[2 * i + 1];
            v4u o; o.x = pk2(a.x, a.y); o.y = pk2(a.z, a.w); o.z = pk2(b.x, b.y); o.w = pk2(b.z, b.w); ((v4u*)WSB)[i] = o; }
    }
    {
        if (lay == 0) { bf16* H = WSP(bf16, WS_H); float* RS1 = WSP(float, WS_RSTD1); const float* xs = inp(F, 0);
            f32x4 vc[4], vn[4];
            if (gw < M) xb_row_load(xs + (size_t)gw * D, vc, lane);
            for (int m = gw; m < M; m += NGW) { const bool hn = m + NGW < M;
                if (hn) xb_row_load(xs + (size_t)(m + NGW) * D, vn, lane);
                xb_row_finish(vc, H + (size_t)m * D, RS1 + m, lane);
                if (hn) {
#pragma unroll
                    for (int j = 0; j < 4; ++j) vc[j] = vn[j]; } } }
        if (lay == 0) { bf16* MEMN = WSP(bf16, WS_MEMN4);
            for (int m = gw; m < DEPTH * MM; m += NGW) { const int lk = m / MM, mr = m % MM; rms_row_bf16(inp(F, 1) + (size_t)mr * D, inp(F, 20) + (size_t)lk * D, MEMN + (size_t)m * D, nullptr, lane); } }
    }
    {
        __syncthreads();
        LAS float* zf = (LAS float*)F.lds;
        LAS float* ha = zf + 16 * 36;
        LAS float* hb = ha + 16 * 64;
        LAS float* lw1 = hb + 16 * 64;
        LAS float* lw2 = lw1 + 33 * 64;
        LAS float* lw3 = lw2 + 64 * 64;
        LAS float* lb = lw3 + 64 * 64;
        const float* fw4 = inp(F, 17) + (size_t)lay * 64 * 1024;
        bf16* KRT = WSP(bf16, WS_FILT);
        const int tid = F.tid;
        { const float* fw1 = inp(F, 11) + (size_t)lay * 33 * 64; const float* fw2 = inp(F, 13) + (size_t)lay * 64 * 64; const float* fw3 = inp(F, 15) + (size_t)lay * 64 * 64;
          { float t1[5], t2[8], t3[8];
#pragma unroll
            for (int k = 0; k < 5; ++k) { const int i = tid + NTHR * k; t1[k] = i < 33 * 64 ? ((const GAS float*)fw1)[i] : 0.f; }
#pragma unroll
            for (int k = 0; k < 8; ++k) { t2[k] = ((const GAS float*)fw2)[tid + NTHR * k]; t3[k] = ((const GAS float*)fw3)[tid + NTHR * k]; }
#pragma unroll
            for (int k = 0; k < 5; ++k) { const int i = tid + NTHR * k; if (i < 33 * 64) lw1[i] = t1[k]; }
#pragma unroll
            for (int k = 0; k < 8; ++k) { lw2[tid + NTHR * k] = t2[k]; lw3[tid + NTHR * k] = t3[k]; } }
          if (tid < 64) { const float* p0 = inp(F, 12) + (size_t)lay * 64; const float* p1 = inp(F, 14) + (size_t)lay * 64; const float* p2 = inp(F, 16) + (size_t)lay * 64; const float* p3 = inp(F, 18) + (size_t)lay * 64;
            const float q0 = ((const GAS float*)p0)[tid], q1 = ((const GAS float*)p1)[tid], q2 = ((const GAS float*)p2)[tid], q3 = ((const GAS float*)p3)[tid];
            lb[tid] = q0; lb[64 + tid] = q1; lb[128 + tid] = q2; lb[192 + tid] = q3; } }
        for (int pos0 = vb * 16; pos0 < L; pos0 += vG * 16) {
            __syncthreads();
            for (int idx = tid; idx < 16 * 33; idx += NTHR) { const int p = idx / 33, j = idx % 33, i = pos0 + p; float val;
                if (j == 0) val = (float)i * (1.0f / 4095.0f);
                else { const int jj = (j - 1) & 15; const float fj = 1e-4f + (float)jj * ((15.0f - 1e-4f) / 15.0f); const float turns = fj * (float)i * (1.0f / 4096.0f);
                       val = (j <= 16) ? cos_turns(turns) : -sin_turns(turns); }
                zf[p * 36 + j] = val; }
            __syncthreads();
            for (int idx = tid; idx < 1024; idx += NTHR) { const int p = idx >> 6, o = idx & 63; float a = lb[o];
                for (int j = 0; j < 33; ++j) a += zf[p * 36 + j] * lw1[j * 64 + o];
                ha[p * 64 + o] = sin_rad(lb[192 + o] * a); }
            __syncthreads();
            for (int idx = tid; idx < 1024; idx += NTHR) { const int p = idx >> 6, o = idx & 63; float a = lb[64 + o];
                for (int j = 0; j < 64; ++j) a += ha[p * 64 + j] * lw2[j * 64 + o];
                hb[p * 64 + o] = sin_rad(lb[192 + o] * a); }
            __syncthreads();
            for (int idx = tid; idx < 1024; idx += NTHR) { const int p = idx >> 6, o = idx & 63; float a = lb[128 + o];
                for (int j = 0; j < 64; ++j) a += hb[p * 64 + j] * lw3[j * 64 + o];
                ha[p * 64 + o] = sin_rad(lb[192 + o] * a); }
            __syncthreads();
            float a0[16], a1[16];
#pragma unroll
            for (int p = 0; p < 16; ++p) { a0[p] = 0.f; a1[p] = 0.f; }
#pragma unroll 1
            for (int ob = 0; ob < 64; ob += 16) { float w0[16], w1v[16];
#pragma unroll
                for (int oo = 0; oo < 16; ++oo) { w0[oo] = fw4[(ob + oo) * 1024 + tid]; w1v[oo] = fw4[(ob + oo) * 1024 + 512 + tid]; }
#pragma unroll
                for (int oo = 0; oo < 16; ++oo)
#pragma unroll
                    for (int p = 0; p < 16; ++p) { const float h = ha[p * 64 + ob + oo]; a0[p] += h * w0[oo]; a1[p] += h * w1v[oo]; } }
            const float min_decay = -3.0701134573253945f, max_decay = -15.350567286626973f;
            const float delta = fabsf(min_decay + (float)tid * ((max_decay - min_decay) / 511.0f));
#pragma unroll
            for (int p = 0; p < 16; ++p) { const float t = (float)(pos0 + p) * (1.0f / 4095.0f); const float dec = __expf(-t * delta); a0[p] *= dec; a1[p] *= dec; }
            bf16* kr = KRT + (size_t)tid * 8192;
            {
                v4u w0, w1;
                w0.x = pk2(a0[15], a0[14]); w0.y = pk2(a0[13], a0[12]); w0.z = pk2(a0[11], a0[10]); w0.w = pk2(a0[9], a0[8]);
                w1.x = pk2(a0[7], a0[6]); w1.y = pk2(a0[5], a0[4]); w1.z = pk2(a0[3], a0[2]); w1.w = pk2(a0[1], a0[0]);
                *(v4u*)(kr + 4080 - pos0) = w0; *(v4u*)(kr + 4088 - pos0) = w1; }
#pragma unroll
            for (int p = 0; p < 16; ++p) { if (pos0 + p > 0) kr[4095 + pos0 + p] = (bf16)f2bf(a1[p]); }
            if (pos0 == L - 16) kr[8191] = 0;
        }
        __syncthreads();
    }
    }
}

__device__ __forceinline__ int xcd_remap(int L_, int nwg) { const int q = nwg / 8, r = nwg % 8, xcd = L_ % 8, off = L_ / 8; return (xcd < r ? xcd * (q + 1) : r * (q + 1) + (xcd - r) * q) + off; }
struct BranchOrder {
    int G, c; pg8::StaticOrder so;
    __device__ __forceinline__ void init(int G_, int c_) { G = G_; c = c_; so.init(M, D, 1, 0); }
    __device__ __forceinline__ bool next(int i, pg8::Unit& u) const {
        const int ti = (i / 3) * G + c, nb = i % 3; if (ti >= 512) return false;
        pg8::Unit t; pg8::StaticOrder s2 = so; s2.G = 1; s2.c = ti; s2.next(0, t);
        u.pm = nb * 128 + t.pm; u.pn = nb * 4 + t.pn; return true; }
    __device__ __forceinline__ void a_ready(const pg8::Unit&) const {}
    __device__ __forceinline__ void done(const pg8::Unit&) const {}
};
struct WinOrder {
    pg8::StaticOrder so;
    __device__ __forceinline__ void init(int G_, int c_) { so.init(M, INC - 1536, G_, c_); }
    __device__ __forceinline__ bool next(int i, pg8::Unit& u) const { if (!so.next(i, u)) return false; if (u.pn >= 4) u.pn += 6; return true; }
    __device__ __forceinline__ void a_ready(const pg8::Unit&) const {}
    __device__ __forceinline__ void done(const pg8::Unit&) const {}
};
struct MoeOrder {
    int G, c, npn;
    __device__ __forceinline__ void init(int G_, int c_, int npn_) { G = G_; c = c_; npn = npn_; }
    __device__ __forceinline__ bool next(int i, pg8::Unit& u) const {
        const int nwg = NE * 16 * npn; const int L_ = i * G + c; if (L_ >= nwg) return false;
        const int w = xcd_remap(L_, nwg); const int per = 16 * npn; const int e = w / per, r = w % per;
        u.pm = e * 16 + r / npn; u.pn = e * npn + r % npn; return true; }
    __device__ __forceinline__ void a_ready(const pg8::Unit&) const {}
    __device__ __forceinline__ void done(const pg8::Unit&) const {}
};

struct EpiKv {
    static constexpr bool PERM = true, AFTER_DRAIN = false;
    bf16* O;
    __device__ __forceinline__ void operator()(const pg8::f32x4 (&acc)[2][2][4][2], const pg8::Unit& u, int wr, int wc, int fr, int fq) const {
        const int row0 = u.pm * 256 + wr * 64 + fr, col0 = (u.pn & 3) * 256 + wc * 32 + 8 * fq;
#pragma unroll
        for (int ai = 0; ai < 2; ++ai)
#pragma unroll
            for (int m = 0; m < 4; ++m) { bf16* rowp = O + (size_t)(row0 + ai * 128 + m * 16) * 1024 + col0;
#pragma unroll
                for (int bj = 0; bj < 2; ++bj) { const pg8::f32x4 v0 = acc[ai][bj][m][0], v1 = acc[ai][bj][m][1];
                    pg8::u32x4 w; w.x = pg8::cvt_pk_bf16(v0[0], v0[1]); w.y = pg8::cvt_pk_bf16(v0[2], v0[3]); w.z = pg8::cvt_pk_bf16(v1[0], v1[1]); w.w = pg8::cvt_pk_bf16(v1[2], v1[3]);
                    *(GAS pg8::u32x4*)(rowp + bj * 128) = w; } }
    }
};
__device__ __forceinline__ unsigned pk4_u8(float a, float b, float c, float d) {
    unsigned w = 0u; w = __builtin_amdgcn_cvt_pk_u8_f32(fmaxf(__builtin_rintf(a * 255.0f), 1.0f), 0, w); w = __builtin_amdgcn_cvt_pk_u8_f32(fmaxf(__builtin_rintf(b * 255.0f), 1.0f), 1, w);
    w = __builtin_amdgcn_cvt_pk_u8_f32(fmaxf(__builtin_rintf(c * 255.0f), 1.0f), 2, w); w = __builtin_amdgcn_cvt_pk_u8_f32(fmaxf(__builtin_rintf(d * 255.0f), 1.0f), 3, w); return w; }
struct EpiCols {
    static constexpr bool PERM = true, AFTER_DRAIN = false;
    bf16 *UV, *P, *Q, *G; const LAS float* gate_b; const float* RS;
    __device__ __forceinline__ void prefetch(const pg8::Unit& u, int wr, int wc, int fr, int fq, float (&pre)[8]) const { const int row0 = u.pm * 256 + wr * 64 + fr;
#pragma unroll
        for (int ai = 0; ai < 2; ++ai)
#pragma unroll
            for (int m = 0; m < 4; ++m) pre[ai * 4 + m] = ((const GAS float*)RS)[row0 + ai * 128 + m * 16]; }
    __device__ __forceinline__ void operator()(const pg8::f32x4 (&acc)[2][2][4][2], const pg8::Unit& u, int wr, int wc, int fr, int fq, const float (&pre)[8]) const {
        const int row0 = u.pm * 256 + wr * 64 + fr; const int pn = u.pn;
        bf16* base; int ldc, colt, mode;
        if (pn < 4) { base = UV; ldc = 1024; colt = pn * 256; mode = 1; }
        else if (pn < 10) { base = P; ldc = 1536; colt = (pn - 4) * 256; mode = 0; }
        else if (pn < 12) { base = Q; ldc = 512; colt = (pn - 10) * 256; mode = 0; }
        else { base = G; ldc = 3072; colt = (pn - 12) * 256; mode = 2; }
        const int col0 = colt + wc * 32 + 8 * fq;
        pg8::f32x4 bv[2][2];
#pragma unroll
        for (int bj = 0; bj < 2; ++bj)
#pragma unroll
            for (int n = 0; n < 2; ++n) bv[bj][n] = (mode == 2) ? *(const LAS pg8::f32x4*)(gate_b + col0 + bj * 128 + 4 * n) : (pg8::f32x4){0.f, 0.f, 0.f, 0.f};
#pragma unroll
        for (int ai = 0; ai < 2; ++ai)
#pragma unroll
            for (int m = 0; m < 4; ++m) { bf16* rowp = base + (size_t)(row0 + ai * 128 + m * 16) * ldc + col0; const float rs = pre[ai * 4 + m];
#pragma unroll
                for (int bj = 0; bj < 2; ++bj) { pg8::f32x4 v0 = acc[ai][bj][m][0] * rs + bv[bj][0], v1 = acc[ai][bj][m][1] * rs + bv[bj][1];
                    if (mode == 1) { pg8::f32x2 a = pg8::gelu_pk((pg8::f32x2){v0[0], v0[1]}), b = pg8::gelu_pk((pg8::f32x2){v0[2], v0[3]}), c = pg8::gelu_pk((pg8::f32x2){v1[0], v1[1]}), d = pg8::gelu_pk((pg8::f32x2){v1[2], v1[3]});
                        v0 = (pg8::f32x4){a.x, a.y, b.x, b.y}; v1 = (pg8::f32x4){c.x, c.y, d.x, d.y}; }
                    else if (mode == 2) {
#pragma unroll
                        for (int j = 0; j < 4; ++j) { v0[j] = sigmoidf_(v0[j]); v1[j] = sigmoidf_(v1[j]); } }
                    if (mode == 2) { v2u w8; w8.x = pk4_u8(v0[0], v0[1], v0[2], v0[3]); w8.y = pk4_u8(v1[0], v1[1], v1[2], v1[3]);
                        __builtin_nontemporal_store(w8, (GAS v2u*)((unsigned char*)G + (size_t)(row0 + ai * 128 + m * 16) * 3072 + col0 + bj * 128)); }
                    else { pg8::u32x4 w; w.x = pg8::cvt_pk_bf16(v0[0], v0[1]); w.y = pg8::cvt_pk_bf16(v0[2], v0[3]); w.z = pg8::cvt_pk_bf16(v1[0], v1[1]); w.w = pg8::cvt_pk_bf16(v1[2], v1[3]);
                        __builtin_nontemporal_store(w, (GAS pg8::u32x4*)(rowp + bj * 128)); } } }
    }
};
struct EpiPT {
    static constexpr bool PERM = true, AFTER_DRAIN = false; static constexpr int NPRE = 16;
    bf16* PT; const float* RS;
    __device__ __forceinline__ void prefetch(const pg8::Unit& u, int wr, int wc, int fr, int fq, float (&pre)[16]) const { const int tok0 = u.pn * 256 + wc * 32 + 8 * fq;
#pragma unroll
        for (int bj = 0; bj < 2; ++bj)
#pragma unroll
            for (int n = 0; n < 2; ++n) { const pg8::f32x4 r = *(const GAS pg8::f32x4*)(RS + tok0 + bj * 128 + 4 * n); pre[bj * 8 + n * 4 + 0] = r[0]; pre[bj * 8 + n * 4 + 1] = r[1]; pre[bj * 8 + n * 4 + 2] = r[2]; pre[bj * 8 + n * 4 + 3] = r[3]; } }
    __device__ __forceinline__ void operator()(const pg8::f32x4 (&acc)[2][2][4][2], const pg8::Unit& u, int wr, int wc, int fr, int fq, const float (&pre)[16]) const {
        const int ch0 = u.pm * 256 + wr * 64 + fr, tok0 = u.pn * 256 + wc * 32 + 8 * fq;
#pragma unroll
        for (int ai = 0; ai < 2; ++ai)
#pragma unroll
            for (int m = 0; m < 4; ++m) { bf16* rowp = PT + (size_t)(ch0 + ai * 128 + m * 16) * PTS + tok0;
#pragma unroll
                for (int bj = 0; bj < 2; ++bj) { const pg8::f32x4 v0 = acc[ai][bj][m][0], v1 = acc[ai][bj][m][1];
                    pg8::u32x4 w; w.x = pg8::cvt_pk_bf16(v0[0] * pre[bj * 8 + 0], v0[1] * pre[bj * 8 + 1]); w.y = pg8::cvt_pk_bf16(v0[2] * pre[bj * 8 + 2], v0[3] * pre[bj * 8 + 3]);
                    w.z = pg8::cvt_pk_bf16(v1[0] * pre[bj * 8 + 4], v1[1] * pre[bj * 8 + 5]); w.w = pg8::cvt_pk_bf16(v1[2] * pre[bj * 8 + 6], v1[3] * pre[bj * 8 + 7]);
                    __builtin_nontemporal_store(w, (GAS pg8::u32x4*)(rowp + bj * 128)); } }
    }
};
constexpr int PAN_WINP = (int)((WS_WIN + (size_t)1024 * D * 2) / (512 * 1024)), PAN_XB = (int)(WS_H / (512 * 1024)), PAN_MEMN = (int)(WS_MEMN4 / (512 * 1024)), PAN_WKV = (int)(WS_WKV4 / (512 * 1024));
static_assert((WS_WIN + (size_t)1024 * D * 2) % (512 * 1024) == 0 && WS_H % (512 * 1024) == 0 && WS_MEMN4 % (512 * 1024) == 0 && WS_WKV4 % (512 * 1024) == 0, "panel alignment");
struct PtKvOrder {
    pg8::StaticOrder so; int G, c, nkv;
    __device__ __forceinline__ void init(int G_, int c_, int nkv_) { so.init(1536, M, G_, c_); G = G_; c = c_; nkv = nkv_; }
    __device__ __forceinline__ bool next(int i, pg8::Unit& u) const {
        if (so.next(i, u)) { u.pm += PAN_WINP; u.pn += PAN_XB; return true; }
        const int L_ = i * G + c - 768; if (L_ < 0 || L_ >= nkv) return false;
        const int lk = L_ >> 5, r = L_ & 31; u.pm = PAN_MEMN + lk * 8 + (r >> 2); u.pn = PAN_WKV + lk * 4 + (r & 3); return true; }
    __device__ __forceinline__ void a_ready(const pg8::Unit&) const {}
    __device__ __forceinline__ void done(const pg8::Unit&) const {}
};
struct EpiPtKv {
    static constexpr bool PERM = true, AFTER_DRAIN = false; static constexpr int NPRE = 16;
    EpiPT pt; EpiKv kv;
    __device__ __forceinline__ void prefetch(const pg8::Unit& u, int wr, int wc, int fr, int fq, float (&pre)[16]) const {
        if (u.pm < PAN_MEMN) { pg8::Unit v; v.pm = u.pm - PAN_WINP; v.pn = u.pn - PAN_XB; pt.prefetch(v, wr, wc, fr, fq, pre); } }
    __device__ __forceinline__ void operator()(const pg8::f32x4 (&acc)[2][2][4][2], const pg8::Unit& u, int wr, int wc, int fr, int fq, const float (&pre)[16]) const {
        if (u.pm < PAN_MEMN) { pg8::Unit v; v.pm = u.pm - PAN_WINP; v.pn = u.pn - PAN_XB; pt(acc, v, wr, wc, fr, fq, pre); }
        else { pg8::Unit v; v.pm = u.pm - PAN_MEMN; v.pn = u.pn - PAN_WKV; kv(acc, v, wr, wc, fr, fq); } }
};
struct EpiBranch {
    static constexpr bool PERM = true, AFTER_DRAIN = false;
    const unsigned char* G; bf16* MERGED;
    __device__ __forceinline__ bool carry(const pg8::Unit& u) const { return (u.pm >> 7) < 2; }
    __device__ __forceinline__ void operator()(pg8::f32x4 (&acc)[2][2][4][2], const pg8::Unit& u, int wr, int wc, int fr, int fq) const {
        const int nb = u.pm >> 7, pm = u.pm & 127, pn = u.pn & 3;
        const int row0 = pm * 256 + wr * 64 + fr, col0 = pn * 256 + wc * 32 + 8 * fq;
        const unsigned char* Ga = G + (size_t)row0 * 3072 + nb * 1024 + col0; const unsigned char* Gb = Ga + (nb < 2 ? 1024 : 0);
        v2u ga[2][4][2], gb[2][4][2];
#pragma unroll
        for (int ai = 0; ai < 2; ++ai)
#pragma unroll
            for (int m = 0; m < 4; ++m)
#pragma unroll
                for (int bj = 0; bj < 2; ++bj) { const size_t o = (size_t)(ai * 128 + m * 16) * 3072 + bj * 128; ga[ai][m][bj] = *(const GAS v2u*)(Ga + o); gb[ai][m][bj] = *(const GAS v2u*)(Gb + o); }
        asm volatile("" ::: "memory");
#pragma unroll
        for (int ai = 0; ai < 2; ++ai) {
#pragma unroll
            for (int m = 0; m < 4; ++m) { const size_t row = (size_t)(row0 + ai * 128 + m * 16);
#pragma unroll
                for (int bj = 0; bj < 2; ++bj) { const int col = col0 + bj * 128;
                    const v2u a = ga[ai][m][bj], b = gb[ai][m][bj];
                    float f[8] = {(float)(a.x & 255u), (float)((a.x >> 8) & 255u), (float)((a.x >> 16) & 255u), (float)(a.x >> 24), (float)(a.y & 255u), (float)((a.y >> 8) & 255u), (float)((a.y >> 16) & 255u), (float)(a.y >> 24)};
                    if (nb < 2) { const float d[8] = {(float)(b.x & 255u), (float)((b.x >> 8) & 255u), (float)((b.x >> 16) & 255u), (float)(b.x >> 24), (float)(b.y & 255u), (float)((b.y >> 8) & 255u), (float)((b.y >> 16) & 255u), (float)(b.y >> 24)};
#pragma unroll
                        for (int k = 0; k < 8; ++k) f[k] *= __builtin_amdgcn_rcpf(fmaxf(d[k], 1.0f)); }
                    else {
#pragma unroll
                        for (int k = 0; k < 8; ++k) f[k] *= (1.0f / 255.0f); }
                    pg8::f32x4 v0 = acc[ai][bj][m][0], v1 = acc[ai][bj][m][1];
                    v0[0] *= f[0]; v0[1] *= f[1]; v0[2] *= f[2]; v0[3] *= f[3]; v1[0] *= f[4]; v1[1] *= f[5]; v1[2] *= f[6]; v1[3] *= f[7];
                    if (nb < 2) { acc[ai][bj][m][0] = v0; acc[ai][bj][m][1] = v1; }
                    else { pg8::u32x4 w; w.x = pg8::cvt_pk_bf16(v0[0], v0[1]); w.y = pg8::cvt_pk_bf16(v0[2], v0[3]); w.z = pg8::cvt_pk_bf16(v1[0], v1[1]); w.w = pg8::cvt_pk_bf16(v1[2], v1[3]);
                        __builtin_nontemporal_store(w, (GAS pg8::u32x4*)(MERGED + row * 1024 + col)); } } } }
    }
};
struct EpiResNorm {
    static constexpr bool PERM = true, AFTER_DRAIN = false;
    bf16* XB; float* PSS;
    __device__ __forceinline__ void operator()(const pg8::f32x4 (&acc)[2][2][4][2], const pg8::Unit& u, int wr, int wc, int fr, int fq) const {
        const int row0 = u.pm * 256 + wr * 64 + fr, col0 = u.pn * 256 + wc * 32 + 8 * fq, lane4 = (fq * 16 + fr) << 2;
        pg8::u32x4 xo[2][4][2];
#pragma unroll
        for (int ai = 0; ai < 2; ++ai)
#pragma unroll
            for (int m = 0; m < 4; ++m)
#pragma unroll
                for (int bj = 0; bj < 2; ++bj) xo[ai][m][bj] = *(const GAS pg8::u32x4*)(XB + (size_t)(row0 + ai * 128 + m * 16) * D + col0 + bj * 128);
        asm volatile("" ::: "memory");
#pragma unroll
        for (int ai = 0; ai < 2; ++ai) {
#pragma unroll
            for (int m = 0; m < 4; ++m) { const size_t row = (size_t)(row0 + ai * 128 + m * 16); float ss = 0.f;
#pragma unroll
                for (int bj = 0; bj < 2; ++bj) { const pg8::u32x4 o = xo[ai][m][bj]; const pg8::f32x4 a = acc[ai][bj][m][0], b = acc[ai][bj][m][1];
                    pg8::u32x4 w; w.x = pg8::cvt_pk_bf16(bflo(o.x) + a[0], bfhi(o.x) + a[1]); w.y = pg8::cvt_pk_bf16(bflo(o.y) + a[2], bfhi(o.y) + a[3]);
                    w.z = pg8::cvt_pk_bf16(bflo(o.z) + b[0], bfhi(o.z) + b[1]); w.w = pg8::cvt_pk_bf16(bflo(o.w) + b[2], bfhi(o.w) + b[3]);
                    *(GAS pg8::u32x4*)(XB + row * D + col0 + bj * 128) = w;
                    ss += ((bflo(w.x) * bflo(w.x) + bfhi(w.x) * bfhi(w.x)) + (bflo(w.y) * bflo(w.y) + bfhi(w.y) * bfhi(w.y))) + ((bflo(w.z) * bflo(w.z) + bfhi(w.z) * bfhi(w.z)) + (bflo(w.w) * bflo(w.w) + bfhi(w.w) * bfhi(w.w))); }
                ss += __builtin_bit_cast(float, __builtin_amdgcn_ds_bpermute(lane4 ^ 64, __builtin_bit_cast(int, ss)));
                ss += __builtin_bit_cast(float, __builtin_amdgcn_ds_bpermute(lane4 ^ 128, __builtin_bit_cast(int, ss)));
                if (fq == 0) ((GAS float*)PSS)[row * 16 + (u.pn & 3) * 4 + wc] = ss; } }
    }
};
struct EpiMoeUp {
    static constexpr bool PERM = true, AFTER_DRAIN = false;
    bf16* HID; const float* RSG;
    __device__ __forceinline__ void prefetch(const pg8::Unit& u, int wr, int wc, int fr, int fq, float (&pre)[8]) const { const int row0 = u.pm * 256 + wr * 64 + fr;
#pragma unroll
        for (int ai = 0; ai < 2; ++ai)
#pragma unroll
            for (int m = 0; m < 4; ++m) pre[ai * 4 + m] = ((const GAS float*)RSG)[row0 + ai * 128 + m * 16]; }
    __device__ __forceinline__ void operator()(const pg8::f32x4 (&acc)[2][2][4][2], const pg8::Unit& u, int wr, int wc, int fr, int fq, const float (&pre)[8]) const {
        const int row0 = u.pm * 256 + wr * 64 + fr, col0 = (u.pn & 7) * 128 + wc * 32 + 8 * fq;
#pragma unroll
        for (int ai = 0; ai < 2; ++ai)
#pragma unroll
            for (int m = 0; m < 4; ++m) { bf16* rowp = HID + (size_t)(row0 + ai * 128 + m * 16) * FF + col0; const float rs = pre[ai * 4 + m];
                pg8::f32x4 h0, h1;
#pragma unroll
                for (int j = 0; j < 4; ++j) { const float a = acc[ai][0][m][0][j] * rs, b = acc[ai][0][m][1][j] * rs;
                    h0[j] = a * sigmoidf_(a) * (acc[ai][1][m][0][j] * rs); h1[j] = b * sigmoidf_(b) * (acc[ai][1][m][1][j] * rs); }
                pg8::u32x4 w; w.x = pg8::cvt_pk_bf16(h0[0], h0[1]); w.y = pg8::cvt_pk_bf16(h0[2], h0[3]); w.z = pg8::cvt_pk_bf16(h1[0], h1[1]); w.w = pg8::cvt_pk_bf16(h1[2], h1[3]);
                __builtin_nontemporal_store(w, (GAS pg8::u32x4*)rowp); }
    }
};
struct EpiMoeDown {
    static constexpr bool PERM = true, AFTER_DRAIN = false;
    bf16* Y; const float* GATE;
    __device__ __forceinline__ void prefetch(const pg8::Unit& u, int wr, int wc, int fr, int fq, float (&pre)[8]) const { const int e = u.pm >> 4; const int rl0 = (u.pm & 15) * 256 + wr * 64 + fr;
#pragma unroll
        for (int ai = 0; ai < 2; ++ai)
#pragma unroll
            for (int m = 0; m < 4; ++m) { const int rl = rl0 + ai * 128 + m * 16; pre[ai * 4 + m] = ((const GAS float*)GATE)[((rl >> 9) * NE + e) * CAP + (rl & 511)]; } }
    __device__ __forceinline__ void operator()(const pg8::f32x4 (&acc)[2][2][4][2], const pg8::Unit& u, int wr, int wc, int fr, int fq, const float (&pre)[8]) const {
        const int e = u.pm >> 4; const int rl0 = (u.pm & 15) * 256 + wr * 64 + fr, col0 = (u.pn & 3) * 256 + wc * 32 + 8 * fq;
#pragma unroll
        for (int ai = 0; ai < 2; ++ai)
#pragma unroll
            for (int m = 0; m < 4; ++m) { const int rl = rl0 + ai * 128 + m * 16; const float gt = pre[ai * 4 + m];
                bf16* rowp = Y + (size_t)(e * 4096 + rl) * D + col0;
#pragma unroll
                for (int bj = 0; bj < 2; ++bj) { const pg8::f32x4 v0 = acc[ai][bj][m][0] * gt, v1 = acc[ai][bj][m][1] * gt;
                    pg8::u32x4 w; w.x = pg8::cvt_pk_bf16(v0[0], v0[1]); w.y = pg8::cvt_pk_bf16(v0[2], v0[3]); w.z = pg8::cvt_pk_bf16(v1[0], v1[1]); w.w = pg8::cvt_pk_bf16(v1[2], v1[3]);
                    __builtin_nontemporal_store(w, (GAS pg8::u32x4*)(rowp + bj * 128)); } }
    }
};

__device__ __forceinline__ void unpack8(const v4u w, float (&x)[8]) { x[0] = bflo(w.x); x[1] = bfhi(w.x); x[2] = bflo(w.y); x[3] = bfhi(w.y); x[4] = bflo(w.z); x[5] = bfhi(w.z); x[6] = bflo(w.w); x[7] = bfhi(w.w); }
__device__ __forceinline__ void load8bf(const bf16* p, float (&x)[8]) {
    const v4u w = *(const v4u*)p;
    x[0] = bflo(w.x); x[1] = bfhi(w.x); x[2] = bflo(w.y); x[3] = bfhi(w.y); x[4] = bflo(w.z); x[5] = bfhi(w.z); x[6] = bflo(w.w); x[7] = bfhi(w.w);
}
constexpr int SG_ROW = 272, SG_ST = 512 * SG_ROW + 64 * 16;
#define SG_AT(c_) ((c_) * SG_ROW + ((c_) >> 3) * 16)
static_assert(SG_ST <= LDSCTL_OFF, "sgu LDS map");
__device__ __forceinline__ void ph_sgu(Frame& F, const Args& A, int lay) {
    typedef float f32x16 __attribute__((ext_vector_type(16)));
    typedef short s16x8 __attribute__((ext_vector_type(8)));
    const bf16* UV = WSP(bf16, WS_UV); bf16* BR0 = WSP(bf16, WS_BR); const bf16* WSB = WSP(bf16, WS_WSB);
    const float* lng = inp(F, 5) + (size_t)lay * BW; const float* lnb = inp(F, 6) + (size_t)lay * BW; const float* sb = inp(F, 8) + (size_t)lay * 4 * 128;
    LAS unsigned char* lds = F.lds;
    const int lane = F.lane, wave = F.wave;
    float gk[8], bk[8];
    { const f32x4 g0 = *(const f32x4*)(lng + 8 * lane), g1 = *(const f32x4*)(lng + 8 * lane + 4), b0 = *(const f32x4*)(lnb + 8 * lane), b1 = *(const f32x4*)(lnb + 8 * lane + 4);
      gk[0] = g0.x; gk[1] = g0.y; gk[2] = g0.z; gk[3] = g0.w; gk[4] = g1.x; gk[5] = g1.y; gk[6] = g1.z; gk[7] = g1.w;
      bk[0] = b0.x; bk[1] = b0.y; bk[2] = b0.z; bk[3] = b0.w; bk[4] = b1.x; bk[5] = b1.y; bk[6] = b1.z; bk[7] = b1.w; }
    const int g = wave >> 1, ph = wave & 1, pl = lane & 31, hh = lane >> 5;
    for (int blk = F.bid; blk < M / 128; blk += F.G) {
        const int row0 = blk * 128;
        v4u vraw[16];
#pragma unroll
        for (int rr = 0; rr < 16; ++rr) vraw[rr] = *(const v4u*)(UV + (size_t)(row0 + 16 * wave + rr) * 1024 + 512 + 8 * lane);
        s16x8 Bf[2][8];
#pragma unroll
        for (int pt = 0; pt < 2; ++pt)
#pragma unroll
            for (int ks = 0; ks < 8; ++ks) Bf[pt][ks] = *(const s16x8*)(WSB + ((size_t)(g * 128 + 64 * ph + 32 * pt + pl) * 128 + 16 * ks + 8 * hh));
        __syncthreads();
#pragma unroll
        for (int q4 = 0; q4 < 4; ++q4) { const int q0 = 16 * wave + 4 * q4;
            float x[4][8], mean[4], rstd[4];
#pragma unroll
            for (int rr = 0; rr < 4; ++rr) unpack8(vraw[4 * q4 + rr], x[rr]);
#pragma unroll
            for (int rr = 0; rr < 4; ++rr) { float s = 0.f;
#pragma unroll
                for (int k = 0; k < 8; ++k) s += x[rr][k];
                mean[rr] = wave_sum(s, lane) * (1.f / 512.f); }
#pragma unroll
            for (int rr = 0; rr < 4; ++rr) { float q = 0.f;
#pragma unroll
                for (int k = 0; k < 8; ++k) { const float d = x[rr][k] - mean[rr]; q += d * d; }
                rstd[rr] = 1.0f / sqrtf(wave_sum(q, lane) * (1.f / 512.f) + 1e-5f); }
#pragma unroll
            for (int k = 0; k < 8; ++k) { float y[4];
#pragma unroll
                for (int rr = 0; rr < 4; ++rr) y[rr] = (x[rr][k] - mean[rr]) * rstd[rr] * gk[k] + bk[k];
                v2u o; o.x = pk2(y[0], y[1]); o.y = pk2(y[2], y[3]);
                *(LAS v2u*)(lds + SG_AT(8 * lane + k) + q0 * 2) = o; } }
        __syncthreads();
        float sbv[2];
#pragma unroll
        for (int pt = 0; pt < 2; ++pt) sbv[pt] = ((const GAS float*)sb)[g * 128 + 64 * ph + 32 * pt + pl];
#pragma unroll 1
        for (int ct = 0; ct < 4; ++ct) {
            const size_t rowA = (size_t)(row0 + 64 * ph + pl); const int cb = g * 128 + 32 * ct + 4 * hh;
            v2u uu[2][4];
#pragma unroll
            for (int pt = 0; pt < 2; ++pt)
#pragma unroll
                for (int j = 0; j < 4; ++j) uu[pt][j] = *(const GAS v2u*)(UV + (rowA + 32 * pt) * 1024 + cb + 8 * j);
            f32x16 C0, C1;
#pragma unroll
            for (int k = 0; k < 16; ++k) { C0[k] = 0.f; C1[k] = 0.f; }
            const LAS unsigned char* bp = lds + SG_AT(g * 128 + 32 * ct + pl) + 16 * hh;
#pragma unroll
            for (int ks = 0; ks < 8; ++ks) { const s16x8 Vf = *(const LAS s16x8*)(bp + 32 * ks);
                C0 = __builtin_amdgcn_mfma_f32_32x32x16_bf16(Vf, Bf[0][ks], C0, 0, 0, 0); C1 = __builtin_amdgcn_mfma_f32_32x32x16_bf16(Vf, Bf[1][ks], C1, 0, 0, 0); }
#pragma unroll
            for (int pt = 0; pt < 2; ++pt)
#pragma unroll
                for (int j = 0; j < 4; ++j) { const v2u uq = uu[pt][j]; const float sbp = sbv[pt];
                    const float c0 = (pt == 0 ? C0[4 * j] : C1[4 * j]) + sbp, c1 = (pt == 0 ? C0[4 * j + 1] : C1[4 * j + 1]) + sbp, c2 = (pt == 0 ? C0[4 * j + 2] : C1[4 * j + 2]) + sbp, c3 = (pt == 0 ? C0[4 * j + 3] : C1[4 * j + 3]) + sbp;
                    v2u o; o.x = pk2(bflo(uq.x) * c0, bfhi(uq.x) * c1); o.y = pk2(bflo(uq.y) * c2, bfhi(uq.y) * c3);
                    *(GAS v2u*)(BR0 + (rowA + 32 * pt) * BW + cb + 8 * j) = o; }
        }
    }
    __syncthreads();
}

__device__ __forceinline__ void shortconv8(const bf16* P, size_t row, int t, int col, const float* cw, const float* cb, float (&o)[8]) {
    float a[8], b[8], c[8];
    load8bf(P + row * 1536 + col, b);
    if (t > 0) load8bf(P + (row - 1) * 1536 + col, a); else {
#pragma unroll
        for (int k = 0; k < 8; ++k) a[k] = 0.f; }
    if (t < L - 1) load8bf(P + (row + 1) * 1536 + col, c); else {
#pragma unroll
        for (int k = 0; k < 8; ++k) c[k] = 0.f; }
#pragma unroll
    for (int k = 0; k < 8; ++k) o[k] = cw[col + k] * a[k] + cw[1536 + col + k] * b[k] + cw[3072 + col + k] * c[k] + cb[col + k];
}
constexpr int HT_ROW = 272;
#define HT_AT(c_, byte_) ((c_) * HT_ROW + ((c_) >> 3) * 16 + (byte_))
__device__ __forceinline__ void conv8(const v4u p, const unsigned pl, const unsigned pr, const float wa, const float wb, const float wc, const float bias, float (&o)[8]) {
    float x[8]; unpack8(p, x); const float xm = bfhi(pl), xp = bflo(pr);
    o[0] = wa * xm + wb * x[0] + wc * x[1] + bias;
#pragma unroll
    for (int k = 1; k < 7; ++k) o[k] = wa * x[k - 1] + wb * x[k] + wc * x[k + 1] + bias;
    o[7] = wa * x[6] + wb * x[7] + wc * xp + bias;
}
constexpr int HY_RS = 8976, HY_KOFF = 8 * HY_RS, HY_CS = 16448;
static_assert(HY_KOFF + 4 * HY_CS <= LDSCTL_OFF, "hyena LDS map");
__device__ __forceinline__ void ph_hyconv(Frame& F, const Args& A, int lay) {
    typedef float f32x16 __attribute__((ext_vector_type(16)));
    typedef short s16x8 __attribute__((ext_vector_type(8)));
    const bf16* PT = WSP(bf16, WS_PT); const bf16* KRT = WSP(bf16, WS_FILT); bf16* YT = WSP(bf16, WS_YT); const float* hbias = inp(F, 19) + (size_t)lay * BW;
    const float* cw = inp(F, 9) + (size_t)lay * 3 * 1536; const float* cb = inp(F, 10) + (size_t)lay * 1536;
    LAS unsigned char* lds = F.lds;
    const int tid = F.tid, lane = F.lane, w = F.wave;
    const int i = lane & 31, g = lane >> 5, r = (3 - i) & 3;
    const int abase = HY_KOFF + r * HY_CS + 2 * (4095 + 8 * g - i - r) - 1024 * w - 64;
    const int dl = i >> 3, bb = i & 7;
    const int bbase = bb * HY_RS + 128 * dl + 16 * g + 384;
    v4u xq[8], vq[8];
#define HY_PREFETCH(c_) do { const bf16* X1_ = PT + (size_t)(512 + (c_)) * PTS + 8 * tid; _Pragma("unroll") for (int b = 0; b < 8; ++b) xq[b] = *(const GAS v4u*)(X1_ + b * L); } while (0)
#define HY_FETCHV(c_) do { const bf16* VV_ = PT + (size_t)(1024 + (c_)) * PTS + 8 * tid; _Pragma("unroll") for (int b = 0; b < 8; ++b) vq[b] = *(const GAS v4u*)(VV_ + b * L); } while (0)
#pragma unroll
    for (int b = 0; b < 8; ++b) { xq[b] = (v4u){0u, 0u, 0u, 0u}; vq[b] = (v4u){0u, 0u, 0u, 0u}; }
    if (F.bid < BW) HY_PREFETCH(F.bid);
    for (int c = F.bid; c < BW; c += F.G) {
        HY_FETCHV(c);
        __syncthreads();
        if (tid < 384) { const int b = tid / 48, k = tid % 48; const int off = b * HY_RS + (k < 24 ? 16 * k : 8576 + 16 * (k - 24)); unsigned z_ = 0u; asm volatile("" : "+v"(z_)); *(LAS v4u*)(lds + off) = (v4u){z_, z_, z_, z_}; }
        {
            const float xa = cw[512 + c], xb = cw[1536 + 512 + c], xc = cw[3072 + 512 + c], xo = cb[512 + c], va = cw[1024 + c], vb = cw[1536 + 1024 + c], vc = cw[3072 + 1024 + c], vo = cb[1024 + c];
            const int lm = ((lane - 1) & 63) << 2, lp = ((lane + 1) & 63) << 2;
            unsigned ex[8], ev[8];
#pragma unroll
            for (int b = 0; b < 8; ++b) { ex[b] = 0u; ev[b] = 0u; }
            int l_ = lane; asm volatile("" : "+v"(l_));
            if (l_ == 0 || l_ == 63) { const bf16* X1_ = PT + (size_t)(512 + c) * PTS + 8 * (64 * w + l_); const bf16* VV_ = PT + (size_t)(1024 + c) * PTS + 8 * (64 * w + l_); const int eo_ = l_ == 0 ? (w > 0 ? -2 : 0) : (w < 7 ? 8 : 0);
#pragma unroll
                for (int b = 0; b < 8; ++b) { ex[b] = *(const GAS unsigned*)(X1_ + b * L + eo_); ev[b] = *(const GAS unsigned*)(VV_ + b * L + eo_); } }
#pragma unroll
            for (int b = 0; b < 8; ++b) { float x1[8], v1[8];
                unsigned xl = (unsigned)__builtin_amdgcn_ds_bpermute(lm, (int)xq[b].w), xr = (unsigned)__builtin_amdgcn_ds_bpermute(lp, (int)xq[b].x);
                unsigned vl = (unsigned)__builtin_amdgcn_ds_bpermute(lm, (int)vq[b].w), vr = (unsigned)__builtin_amdgcn_ds_bpermute(lp, (int)vq[b].x);
                if (lane == 0) { xl = tid > 0 ? ex[b] : 0u; vl = tid > 0 ? ev[b] : 0u; }
                if (lane == 63) { xr = tid < 511 ? ex[b] : 0u; vr = tid < 511 ? ev[b] : 0u; }
                conv8(xq[b], xl, xr, xa, xb, xc, xo, x1); conv8(vq[b], vl, vr, va, vb, vc, vo, v1);
                v4u o; o.x = pk2(x1[0] * v1[0], x1[1] * v1[1]); o.y = pk2(x1[2] * v1[2], x1[3] * v1[3]); o.z = pk2(x1[4] * v1[4], x1[5] * v1[5]); o.w = pk2(x1[6] * v1[6], x1[7] * v1[7]);
                *(LAS v4u*)(lds + b * HY_RS + 384 + 16 * tid) = o; } }
        const v4u wq[2] = {*(const GAS v4u*)(KRT + (size_t)c * 8192 + 8 * tid), *(const GAS v4u*)(KRT + (size_t)c * 8192 + 8 * (tid + NTHR))};
#pragma unroll
        for (int k2 = 0; k2 < 2; ++k2) { const int k = tid + NTHR * k2; const v4u wv = wq[k2];
            *(LAS v4u*)(lds + HY_KOFF + 16 * k) = wv;
            const unsigned ww[4] = {wv.x, wv.y, wv.z, wv.w};
#pragma unroll
            for (int rr = 1; rr < 4; ++rr)
#pragma unroll
                for (int jj = 0; jj < 8; ++jj) { const int q = 8 * k + jj - rr; const bf16 el = (bf16)((jj & 1) ? (ww[jj >> 1] >> 16) : (ww[jj >> 1] & 0xffffu));
                    if (q >= 0) *(LAS bf16*)(lds + HY_KOFF + rr * HY_CS + 2 * q) = el; } }
        __syncthreads();
        if (c + F.G < BW) HY_PREFETCH(c + F.G);
        f32x16 C00, C01, C10, C11;
#pragma unroll
        for (int k = 0; k < 16; ++k) { C00[k] = 0.f; C01[k] = 0.f; C10[k] = 0.f; C11[k] = 0.f; }
        s16x8 FA[6], FB[6], Q0[4], Q1[4], Q2[4], Q3[4];
#define HY_LD1(dst, ao_, o_) do { const v2u lo_ = *(const LAS v2u*)(lds + (ao_) + 32 * (o_)), hi_ = *(const LAS v2u*)(lds + (ao_) + 32 * (o_) + 8); const v4u q4_ = {lo_.x, lo_.y, hi_.x, hi_.y}; dst = __builtin_bit_cast(s16x8, q4_); } while (0)
#define HY_LD6(FF, S0_) do { int ao_ = abase + 128 * (S0_); asm volatile("" : "+v"(ao_)); _Pragma("unroll") for (int o = 0; o < 6; ++o) HY_LD1(FF[o], ao_, o); } while (0)
#define HY_LD4(FN, FP, S0_) do { int ao_ = abase + 128 * (S0_); asm volatile("" : "+v"(ao_)); FN[0] = FP[4]; FN[1] = FP[5]; _Pragma("unroll") for (int o = 2; o < 6; ++o) HY_LD1(FN[o], ao_, o); } while (0)
#define HY_LDQ(QQ, S0_) do { if ((S0_) <= 59) { const int bo_ = bbase + 128 * (S0_) + 512; _Pragma("unroll") for (int jp = 0; jp < 4; ++jp) QQ[jp] = *(const LAS s16x8*)(lds + bo_ + 32 * jp); } } while (0)
#define HY_MM0(FF, BB, S0_) do { if ((S0_) >= -3) { _Pragma("unroll") for (int jp = 0; jp < 4; ++jp) { C00 = __builtin_amdgcn_mfma_f32_32x32x16_bf16(FF[2 + jp], BB[jp], C00, 0, 0, 0); C01 = __builtin_amdgcn_mfma_f32_32x32x16_bf16(FF[jp], BB[jp], C01, 0, 0, 0); } } } while (0)
#define HY_MM1(FF, BB, S0_) do { if ((S0_) <= 59) { _Pragma("unroll") for (int jp = 0; jp < 4; ++jp) { C10 = __builtin_amdgcn_mfma_f32_32x32x16_bf16(FF[2 + jp], BB[jp], C10, 0, 0, 0); C11 = __builtin_amdgcn_mfma_f32_32x32x16_bf16(FF[jp], BB[jp], C11, 0, 0, 0); } } } while (0)
#define HY_SB() __builtin_amdgcn_sched_barrier(0)
#define HY_STEP(FC, FN, QQ, S0_) do { HY_LD4(FN, FC, (S0_) + 1); HY_SB(); HY_MM0(FC, QQ, S0_); HY_SB(); HY_LDQ(QQ, S0_); HY_SB(); HY_MM1(FC, QQ, S0_); HY_SB(); } while (0)
        HY_LD6(FA, -7);
#pragma unroll 1
        for (int S0 = -7; S0 <= 57; S0 += 4) { HY_STEP(FA, FB, Q0, S0); HY_STEP(FB, FA, Q1, S0 + 1); HY_STEP(FA, FB, Q2, S0 + 2); HY_STEP(FB, FA, Q3, S0 + 3); }
        HY_STEP(FA, FB, Q0, 61); HY_STEP(FB, FA, Q1, 62); HY_MM0(FA, Q2, 63);
#undef HY_LDQ
#undef HY_STEP
#undef HY_PREFETCH
#undef HY_FETCHV
#undef HY_LD1
#undef HY_LD6
#undef HY_LD4
#undef HY_MM0
#undef HY_MM1
#undef HY_SB
        const float hb = hbias[c];
        bf16* yrow = YT + ((size_t)c * NB + bb) * L + 512 * w + 64 * dl + 4 * g;
        const LAS unsigned char* urow = lds + bb * HY_RS + 384 + 2 * (512 * w + 64 * dl + 4 * g);
#define HY_ST(CC, tile, ip) do { _Pragma("unroll") for (int r4 = 0; r4 < 4; ++r4) { const v2u u4 = *(const LAS v2u*)(urow + 2 * (256 * (tile) + 32 * (ip) + 8 * r4)); \
            v2u o; o.x = pk2(CC[4 * r4] + hb * bflo(u4.x), CC[4 * r4 + 1] + hb * bfhi(u4.x)); o.y = pk2(CC[4 * r4 + 2] + hb * bflo(u4.y), CC[4 * r4 + 3] + hb * bfhi(u4.y)); \
            *(GAS v2u*)(yrow + 256 * (tile) + 32 * (ip) + 8 * r4) = o; } } while (0)
        HY_ST(C00, 0, 0); HY_ST(C01, 0, 1); HY_ST(C10, 1, 0); HY_ST(C11, 1, 1);
#undef HY_ST
    }
    __syncthreads();
}
__device__ __forceinline__ void ph_hygate(Frame& F, const Args& A, int lay) {
    const bf16* PT = WSP(bf16, WS_PT); const bf16* YT = WSP(bf16, WS_YT); bf16* BR1 = WSP(bf16, WS_BR) + (size_t)M * BW;
    const float* cw = inp(F, 9) + (size_t)lay * 3 * 1536; const float* cb = inp(F, 10) + (size_t)lay * 1536;
    LAS unsigned char* T = F.lds; const int tid = F.tid;
    const int cl = tid >> 3, k16 = tid & 7, tl = tid >> 3, c8 = (tid & 7) * 8;
    v4u yn, pn; unsigned ln, rn; float wn[4];
#define HG_FETCH(tile_) do { const int b_ = (tile_) >> 9, tt_ = ((tile_) >> 3) & 63, c0_ = ((tile_) & 7) * 64, t_ = tt_ * 64 + 8 * k16; \
        const size_t o_ = ((size_t)(c0_ + cl) * NB + b_) * L + t_, q_ = (size_t)(c0_ + cl) * PTS + (size_t)b_ * L + t_; yn = *(const GAS v4u*)(YT + o_); pn = *(const GAS v4u*)(PT + q_); \
        ln = *(const GAS unsigned*)(PT + q_ - (t_ > 0 ? 2 : 0)); rn = *(const GAS unsigned*)(PT + q_ + (t_ < L - 8 ? 8 : 0)); \
        wn[0] = cw[c0_ + cl]; wn[1] = cw[1536 + c0_ + cl]; wn[2] = cw[3072 + c0_ + cl]; wn[3] = cb[c0_ + cl]; } while (0)
    if (F.bid < 4096) HG_FETCH(F.bid);
    for (int tile = F.bid; tile < 4096; tile += F.G) {
        const int b = tile >> 9, tt = (tile >> 3) & 63, cblk = tile & 7, c0 = cblk * 64, t0 = tt * 64;
        const v4u yv = yn, pv = pn; const int tq = t0 + 8 * k16; const unsigned lv = tq > 0 ? ln : 0u, rv = tq < L - 8 ? rn : 0u; const float w0 = wn[0], w1 = wn[1], w2 = wn[2], w3 = wn[3];
        if (tile + F.G < 4096) HG_FETCH(tile + F.G);
        float x0[8], y[8]; conv8(pv, lv, rv, w0, w1, w2, w3, x0); unpack8(yv, y);
        v4u zv; zv.x = pk2(x0[0] * y[0], x0[1] * y[1]); zv.y = pk2(x0[2] * y[2], x0[3] * y[3]); zv.z = pk2(x0[4] * y[4], x0[5] * y[5]); zv.w = pk2(x0[6] * y[6], x0[7] * y[7]);
        __syncthreads();
        *(LAS v4u*)(T + HT_AT(cl, k16 * 16)) = zv;
        __syncthreads();
        unsigned short e[8];
#pragma unroll
        for (int k = 0; k < 8; ++k) e[k] = *(const LAS bf16*)(T + HT_AT(c8 + k, tl * 2));
        v4u wv; wv.x = (unsigned)e[0] | ((unsigned)e[1] << 16); wv.y = (unsigned)e[2] | ((unsigned)e[3] << 16); wv.z = (unsigned)e[4] | ((unsigned)e[5] << 16); wv.w = (unsigned)e[6] | ((unsigned)e[7] << 16);
        *(GAS v4u*)(BR1 + ((size_t)b * L + t0 + tl) * BW + c0 + c8) = wv;
    }
#undef HG_FETCH
    __syncthreads();
}

__device__ __forceinline__ void ph_attn(Frame& F, int lay) {
    const bf16* Q = WSP(bf16, WS_Q); const bf16* KV = WSP(bf16, WS_KV4) + (size_t)lay * MM * 1024; bf16* BR2 = WSP(bf16, WS_BR) + (size_t)2 * M * BW;
    for (int p = F.bid; p < 256; p += F.G) { const int bh = p >> 3, b = bh >> 2, h = bh & 3, qb0 = (p & 7) * 2;
        const bf16* Qb = Q + ((size_t)(b * L + qb0 * 256) * 512 + h * 128); const bf16* Kh = KV + (size_t)(b * MEML) * 1024 + h * 128;
        __syncthreads();
        attn::attn_resident<2>(Qb, Kh, Kh + 512, BR2 + ((size_t)(b * L + qb0 * 256) * 512 + h * 128), (char*)F.lds, F.tid);
    }
    __syncthreads();
}

__device__ __forceinline__ float bperm_f(int srclane, float v) { return __builtin_bit_cast(float, __builtin_amdgcn_ds_bpermute(srclane << 2, __builtin_bit_cast(int, v))); }
__device__ __forceinline__ float reduce16(const float (&lg)[16], int lane) {
    float t8[8], t4[4], t2[2];
    const bool h5 = (lane & 32) != 0, h4 = (lane & 16) != 0, h3 = (lane & 8) != 0, h2 = (lane & 4) != 0;
#pragma unroll
    for (int k = 0; k < 8; ++k) { const float mine = h5 ? lg[8 + k] : lg[k], other = h5 ? lg[k] : lg[8 + k]; t8[k] = mine + bperm_f(lane ^ 32, other); }
#pragma unroll
    for (int k = 0; k < 4; ++k) { const float mine = h4 ? t8[4 + k] : t8[k], other = h4 ? t8[k] : t8[4 + k]; t4[k] = mine + bperm_f(lane ^ 16, other); }
#pragma unroll
    for (int k = 0; k < 2; ++k) { const float mine = h3 ? t4[2 + k] : t4[k], other = h3 ? t4[k] : t4[2 + k]; t2[k] = mine + bperm_f(lane ^ 8, other); }
    float t1; { const float mine = h2 ? t2[1] : t2[0], other = h2 ? t2[0] : t2[1]; t1 = mine + bperm_f(lane ^ 4, other); }
    t1 += bperm_f(lane ^ 2, t1); t1 += bperm_f(lane ^ 1, t1);
    return t1;
}
constexpr int WR_ROW = 2064;
__device__ __forceinline__ void ph_norm2(Frame& F, const Args& A, int lay) {
    typedef short s16x8 __attribute__((ext_vector_type(8)));
    LAS unsigned char* lds = F.lds;
    const float* wrg = inp(F, 25) + (size_t)lay * D * NE; const float* g2 = inp(F, 24) + (size_t)lay * D;
    const bf16* XG = WSP(bf16, WS_H); float* AFF = WSP(float, WS_AFF); float* RS2 = WSP(float, WS_RSTD2); const float* PSS = WSP(float, WS_MSUM);
    const int lane = F.lane;
    const int gw = F.vcu * NWAVES + F.wave, NGW = F.G * NWAVES;
    const int r = lane & 15, kg = lane >> 4;
    int slab = gw; bool have = slab < M / 16;
    s16x8 xa[32]; f32x4 ps = {0.f, 0.f, 0.f, 0.f};
#define N2_LOAD() do { const bf16* xp_ = XG + (size_t)(slab * 16 + r) * D + 8 * kg; _Pragma("unroll") for (int s = 0; s < 32; ++s) xa[s] = *(const GAS s16x8*)(xp_ + 32 * s); \
        ps = *(const GAS f32x4*)(PSS + (size_t)(slab * 16 + r) * 16 + 4 * kg); } while (0)
#pragma unroll
    for (int s = 0; s < 32; ++s) xa[s] = (s16x8){0, 0, 0, 0, 0, 0, 0, 0};
    if (have) N2_LOAD();
    __syncthreads();
#pragma unroll 1
    for (int i0 = F.tid; i0 < D * NE; i0 += 8 * NTHR) { float wv[8], gq[8];
#pragma unroll
        for (int q = 0; q < 8; ++q) { const int i = i0 + NTHR * q; wv[q] = ((const GAS float*)wrg)[i]; gq[q] = ((const GAS float*)g2)[i >> 4]; }
#pragma unroll
        for (int q = 0; q < 8; ++q) { const int i = i0 + NTHR * q, k = i >> 4, e = i & 15; *(LAS bf16*)(lds + e * WR_ROW + 2 * k) = (bf16)f2bf(wv[q] * gq[q]); } }
    __syncthreads();
    const LAS unsigned char* bp = lds + r * WR_ROW + 16 * kg;
    while (have) { const int row0 = slab * 16;
        f32x4 acc = {0.f, 0.f, 0.f, 0.f};
#pragma unroll
        for (int s = 0; s < 32; ++s) { const s16x8 Bf = *(const LAS s16x8*)(bp + 64 * s); acc = __builtin_amdgcn_mfma_f32_16x16x32_bf16(xa[s], Bf, acc, 0, 0, 0); }
        float ss = (ps.x + ps.y) + (ps.z + ps.w);
        ss += bperm_f(lane ^ 16, ss); ss += bperm_f(lane ^ 32, ss);
        const float rstd = 1.0f / sqrtf(ss * (1.f / 1024.f) + 1e-6f);
        if (kg == 0) RS2[row0 + r] = rstd;
        f32x4 pv;
#pragma unroll
        for (int rg = 0; rg < 4; ++rg) {
            const float lg = acc[rg] * bperm_f(4 * kg + rg, rstd);
            float mx = lg;
#pragma unroll
            for (int o = 1; o < 16; o <<= 1) mx = fmaxf(mx, bperm_f(lane ^ o, mx));
            const float ex = __expf(lg - mx); float den = ex;
#pragma unroll
            for (int o = 1; o < 16; o <<= 1) den += bperm_f(lane ^ o, den);
            pv[rg] = ex / den; }
        const int b = row0 >> 12, t0 = (row0 & (L - 1)) + 4 * kg;
        *(GAS f32x4*)(AFF + ((size_t)(b * NE + r)) * L + t0) = pv;
        slab += NGW; have = slab < M / 16;
        if (have) N2_LOAD();
    }
#undef N2_LOAD
    __syncthreads();
}

typedef unsigned long long u64_t;
__device__ __forceinline__ void ph_topk(Frame& F) {
    LAS unsigned* hist = (LAS unsigned*)F.lds;
    LAS unsigned* ctl = hist + 256;
    const float* AFF = WSP(float, WS_AFF); int* IDX = WSP(int, WS_IDX); float* GATE = WSP(float, WS_GATE); int* INV = WSP(int, WS_INV);
    unsigned* RMAP = WSP(unsigned, WS_RMAP); float* RSG = WSP(float, WS_RSG); const float* RS2 = WSP(float, WS_RSTD2);
    const int tid = F.tid, lane = F.lane, wave = F.wave;
    for (int pr = F.bid; pr < NB * NE; pr += F.G) {
        u64_t k8[8];
        { const f32x4 a = ((const f32x4*)(AFF + (size_t)pr * L))[2 * tid], b = ((const f32x4*)(AFF + (size_t)pr * L))[2 * tid + 1];
          const float av[8] = {a.x, a.y, a.z, a.w, b.x, b.y, b.z, b.w};
#pragma unroll
          for (int r = 0; r < 8; ++r) k8[r] = ((u64_t)__builtin_bit_cast(unsigned, av[r]) << 12) | (unsigned)(L - 1 - (8 * tid + r)); }
        u64_t prefix = 0; unsigned need = CAP;
#pragma unroll 1
        for (int pass = 0; pass < 6; ++pass) { const int shift = 40 - 8 * pass;
            __syncthreads();
            if (tid < 256) hist[tid] = 0u;
            __syncthreads();
#pragma unroll
            for (int r = 0; r < 8; ++r) if ((k8[r] >> (shift + 8)) == prefix) __hip_atomic_fetch_add(hist + (unsigned)((k8[r] >> shift) & 255u), 1u, __ATOMIC_RELAXED, __HIP_MEMORY_SCOPE_WORKGROUP);
            __syncthreads();
            if (wave == 0) {
                const unsigned c0 = hist[4 * lane], c1 = hist[4 * lane + 1], c2 = hist[4 * lane + 2], c3 = hist[4 * lane + 3];
                const unsigned sl = c0 + c1 + c2 + c3; unsigned S = sl;
#pragma unroll
                for (int o = 1; o < 64; o <<= 1) { const unsigned t = (unsigned)__builtin_amdgcn_ds_bpermute(((lane + o) & 63) << 2, (int)S); S += (lane + o < 64) ? t : 0u; }
                unsigned above = S - sl;
                if (above < need && need <= above + sl) {
                    int dg; unsigned nd;
                    if (need <= above + c3) { dg = 3; nd = need - above; } else { above += c3;
                    if (need <= above + c2) { dg = 2; nd = need - above; } else { above += c2;
                    if (need <= above + c1) { dg = 1; nd = need - above; } else { above += c1; dg = 0; nd = need - above; } } }
                    ctl[0] = (unsigned)(4 * lane + dg); ctl[1] = nd; }
            }
            __syncthreads();
            prefix = (prefix << 8) | ctl[0]; need = ctl[1];
        }
        unsigned sel = 0u, cnt = 0u;
#pragma unroll
        for (int r = 0; r < 8; ++r) { const bool s1 = k8[r] >= prefix; sel |= (s1 ? 1u : 0u) << r; cnt += s1 ? 1u : 0u; }
        unsigned inc = cnt;
#pragma unroll
        for (int o = 1; o < 64; o <<= 1) { const unsigned t = (unsigned)__builtin_amdgcn_ds_bpermute(((lane - o) & 63) << 2, (int)inc); inc += (lane >= o) ? t : 0u; }
        __syncthreads();
        if (lane == 63) ctl[8 + wave] = inc;
        __syncthreads();
        unsigned base = 0u;
#pragma unroll
        for (int w = 0; w < 8; ++w) base += (w < wave) ? ctl[8 + w] : 0u;
        unsigned pos = base + inc - cnt;
        const int b = pr >> 4, e = pr & 15;
        const f32x4 rq0 = *(const GAS f32x4*)(RS2 + b * L + 8 * tid), rq1 = *(const GAS f32x4*)(RS2 + b * L + 8 * tid + 4); const float rq[8] = {rq0.x, rq0.y, rq0.z, rq0.w, rq1.x, rq1.y, rq1.z, rq1.w};
#pragma unroll
        for (int r = 0; r < 8; ++r) { const int tok = 8 * tid + r; const bool s1 = (sel >> r) & 1u;
            INV[(size_t)pr * L + tok] = s1 ? (int)pos : -1;
            if (s1) { IDX[(size_t)pr * CAP + pos] = tok; GATE[(size_t)pr * CAP + pos] = __builtin_bit_cast(float, (unsigned)(k8[r] >> 12));
                const int grow = (e * NB + b) * CAP + (int)pos;
                RMAP[grow] = (unsigned)(b * L + tok) * (unsigned)(D * 2); RSG[grow] = rq[r]; ++pos; } }
    }
    __syncthreads();
}
__device__ __forceinline__ void ph_combine(Frame& F, const Args& A, int lay) {
    const int* INV = WSP(int, WS_INV); const bf16* Y = WSP(bf16, WS_Y); bf16* XB = WSP(bf16, WS_H); float* RS1 = WSP(float, WS_RSTD1);
    const bool last = (lay + 1 == DEPTH);
    const float* gn = inp(F, 29);
    const int gw = F.vcu * NWAVES + F.wave, NGW = F.G * NWAVES, lane = F.lane;
    LAS unsigned char* stg = F.lds + F.wave * 16384;
    f32x4 gfin[4] = {{0.f, 0.f, 0.f, 0.f}, {0.f, 0.f, 0.f, 0.f}, {0.f, 0.f, 0.f, 0.f}, {0.f, 0.f, 0.f, 0.f}};
    if (last) {
#pragma unroll
        for (int q = 0; q < 4; ++q) gfin[q] = ((const GAS f32x4*)gn)[2 * (lane + 64 * (q >> 1)) + (q & 1)]; }
    int inv_n = -1; v4u vn[4][2];
#define CB_FETCH(M0_) do { const int b_ = (M0_) >> 12, t_ = (M0_) & (L - 1); inv_n = INV[((size_t)(b_ * NE + (lane & 15)) << 12) + t_ + (lane >> 4)]; \
        _Pragma("unroll") for (int rr = 0; rr < 4; ++rr) { const GAS v4u* xr_ = (const GAS v4u*)(XB + (size_t)((M0_) + rr) * D) + lane; _Pragma("unroll") for (int j = 0; j < 2; ++j) vn[rr][j] = xr_[64 * j]; } } while (0)
    if (4 * gw < M) CB_FETCH(4 * gw);
    for (int m0 = 4 * gw; m0 < M; m0 += 4 * NGW) {
        const int b = m0 >> 12;
        const int inv = inv_n;
        f32x4 v[4][4];
#pragma unroll
        for (int rr = 0; rr < 4; ++rr)
#pragma unroll
            for (int j = 0; j < 2; ++j) { const v4u q = vn[rr][j]; v[rr][2 * j] = (f32x4){bflo(q.x), bfhi(q.x), bflo(q.y), bfhi(q.y)}; v[rr][2 * j + 1] = (f32x4){bflo(q.z), bfhi(q.z), bflo(q.w), bfhi(q.w)}; }
        if (m0 + 4 * NGW < M) CB_FETCH(m0 + 4 * NGW);
        unsigned long long mask = __ballot(inv >= 0);
        while (mask) {
            unsigned long long mm = mask;
#pragma unroll 1
            for (int sI = 0; sI < 8 && mm; ++sI) { { const int k = __builtin_ctzll(mm); mm &= mm - 1; const int sl = __builtin_amdgcn_readlane(inv, k); const int e = k & 15;
                const char* yr = (const char*)(Y + (size_t)((e * NB + b) * CAP + sl) * D) + lane * 16;
                __builtin_amdgcn_global_load_lds((const unsigned*)yr, (LAS unsigned*)(stg + sI * 2048), 16, 0, 0);
                __builtin_amdgcn_global_load_lds((const unsigned*)(yr + 1024), (LAS unsigned*)(stg + sI * 2048 + 1024), 16, 0, 0); } }
            asm volatile("s_waitcnt vmcnt(0)" ::: "memory");
            mm = mask;
#pragma unroll 1
            for (int sI = 0; sI < 8 && mm; ++sI) { { const int k = __builtin_ctzll(mm); mm &= mm - 1; const int rr = k >> 4;
                v4u w[2];
#pragma unroll
                for (int j = 0; j < 2; ++j) w[j] = *(const LAS v4u*)(stg + sI * 2048 + 16 * lane + 1024 * j);
#define CB_ADD(RR) do { _Pragma("unroll") for (int j = 0; j < 2; ++j) { v[RR][2 * j].x += bflo(w[j].x); v[RR][2 * j].y += bfhi(w[j].x); v[RR][2 * j].z += bflo(w[j].y); v[RR][2 * j].w += bfhi(w[j].y); \
                    v[RR][2 * j + 1].x += bflo(w[j].z); v[RR][2 * j + 1].y += bfhi(w[j].z); v[RR][2 * j + 1].z += bflo(w[j].w); v[RR][2 * j + 1].w += bfhi(w[j].w); } } while (0)
                if (rr == 0) CB_ADD(0); else if (rr == 1) CB_ADD(1); else if (rr == 2) CB_ADD(2); else CB_ADD(3);
#undef CB_ADD
            } }
            asm volatile("s_waitcnt lgkmcnt(0)" ::: "memory");
            mask = mm;
        }
#pragma unroll
        for (int rr = 0; rr < 4; ++rr) {
            if (last) { float s = 0.f;
#pragma unroll
                for (int q = 0; q < 4; ++q) s += (v[rr][q].x * v[rr][q].x + v[rr][q].y * v[rr][q].y) + (v[rr][q].z * v[rr][q].z + v[rr][q].w * v[rr][q].w);
                const float rstd = 1.0f / sqrtf(wave_sum(s, lane) * (1.f / 1024.f) + 1e-6f);
                GAS f32x4* xr = (GAS f32x4*)(F.x + (size_t)(m0 + rr) * D);
#pragma unroll
                for (int q = 0; q < 4; ++q) { const f32x4 gv = gfin[q]; f32x4 o; o.x = v[rr][q].x * rstd * gv.x; o.y = v[rr][q].y * rstd * gv.y; o.z = v[rr][q].z * rstd * gv.z; o.w = v[rr][q].w * rstd * gv.w;
                    xr[2 * (lane + 64 * (q >> 1)) + (q & 1)] = o; }
            } else { float s = 0.f;
                GAS v4u* o8 = (GAS v4u*)(XB + (size_t)(m0 + rr) * D) + lane;
#pragma unroll
                for (int j = 0; j < 2; ++j) { v4u o; o.x = pk2(v[rr][2 * j].x, v[rr][2 * j].y); o.y = pk2(v[rr][2 * j].z, v[rr][2 * j].w); o.z = pk2(v[rr][2 * j + 1].x, v[rr][2 * j + 1].y); o.w = pk2(v[rr][2 * j + 1].z, v[rr][2 * j + 1].w); o8[64 * j] = o;
                    s += ((bflo(o.x) * bflo(o.x) + bfhi(o.x) * bfhi(o.x)) + (bflo(o.y) * bflo(o.y) + bfhi(o.y) * bfhi(o.y))) + ((bflo(o.z) * bflo(o.z) + bfhi(o.z) * bfhi(o.z)) + (bflo(o.w) * bflo(o.w) + bfhi(o.w) * bfhi(o.w))); }
                const float rstd = 1.0f / sqrtf(wave_sum(s, lane) * (1.f / 1024.f) + 1e-6f);
                if (lane == 0) RS1[m0 + rr] = rstd;
            } }
    }
#undef CB_FETCH
    __syncthreads();
}

__global__ void __launch_bounds__(NTHR, 2) mk_fwd(Args args) {
    extern __shared__ __attribute__((aligned(16))) unsigned char lds[];
    Frame F;
#define FRESH() do { int wv_ = wave0; unsigned m_ = ~0u; asm volatile("" : "+s"(wv_), "+s"(m_)); F.lane = (int)__builtin_amdgcn_mbcnt_hi(m_, __builtin_amdgcn_mbcnt_lo(m_, 0u)); F.wave = wv_; F.tid = wv_ * 64 + F.lane; \
        int g_ = gridDim.x, b_ = blockIdx.x; asm volatile("" : "+s"(g_), "+s"(b_)); F.G = g_; F.bid = b_; F.vcu = (g_ % 8 == 0) ? (b_ % 8) * (g_ / 8) + b_ / 8 : b_; \
        unsigned l_ = 0; asm volatile("" : "+s"(l_)); F.lds = (LAS unsigned char*)lds + l_; F.MISC = (volatile LAS unsigned*)(F.lds + MISC_OFF); \
        unsigned char* w_ = args.ws; asm volatile("" : "+s"(w_)); F.ws = (unsigned char*)(GAS unsigned char*)w_; F.ctl = (unsigned*)(F.ws + WS_CTL); float* x_ = args.out; asm volatile("" : "+s"(x_)); F.x = (float*)(GAS float*)x_; } while (0)
    const int wave0 = __builtin_amdgcn_readfirstlane((int)(threadIdx.x >> 6));
    FRESH();
    for (int u = F.tid; u < (LDS_BYTES - LDSCTL_OFF) / 4; u += NTHR) ((LAS unsigned*)(F.lds + LDSCTL_OFF))[u] = 0u;
    __syncthreads();
    if (F.tid == 0) { LAS unsigned long long* tab = (LAS unsigned long long*)(F.lds + TAB_OFF);
#pragma unroll
        for (int k = 0; k < 30; ++k) tab[k] = (unsigned long long)args.in[k]; }
    __syncthreads();
    XcdBarrier bar; bar.bar = F.ctl + CW_BAR; bar.x = 0; bar.st = nullptr;
    const bool multi = (args.s_hi - args.s_lo) > 1;
    if (multi) bar = xcd_barrier_post(F.ctl + CW_BAR, F.MISC + 8);
    const int s_lo = args.s_lo, s_hi = args.s_hi;
#ifndef PHMASK
#define PHMASK 0xFFFFF
#endif
#define ACTIVE(s) (((PHMASK >> (((s) == DEPTH * NPH) ? 12 : ((s) % NPH))) & 1) && s_lo <= (s) && (s) < s_hi)
#ifndef DUPMASK
#define DUPMASK 0
#endif
#define REP(k) _Pragma("unroll") for (int rep_ = 0; rep_ < (((DUPMASK) >> (k)) & 1) + 1; ++rep_)
#define SEAM(s) do { if ((s) + 1 < s_hi) { XcdBarrier b2_ = bar; asm volatile("" : "+s"(b2_.bar), "+s"(b2_.x)); xcd_barrier(b2_); } } while (0)
    for (int lay = 0; lay < DEPTH; ++lay) {
        const int s0 = lay * NPH;
        if (lay == 0 && ACTIVE(s0 + 0)) { REP(0) { FRESH(); ph_prep(F, args, 0); } SEAM(s0 + 0); }
        if (ACTIVE(s0 + 1)) { REP(1) { FRESH();
            { pg8::Gemm g{WSP(bf16, WS_H), WSP(bf16, WS_WIN), M, INC, D}; WinOrder S; S.init(F.G, F.bid);
              LAS float* gbl = (LAS float*)(F.lds + ROWTAB_OFF);
              { const float* gb = inp(F, 4) + (size_t)lay * 3 * D; __syncthreads();
                float q[6];
#pragma unroll
                for (int k = 0; k < 6; ++k) q[k] = ((const GAS float*)gb)[F.tid + NTHR * k];
#pragma unroll
                for (int k = 0; k < 6; ++k) gbl[F.tid + NTHR * k] = q[k];
                __syncthreads(); }
              EpiCols E{WSP(bf16, WS_UV), WSP(bf16, WS_P), WSP(bf16, WS_Q), WSP(bf16, WS_G), gbl, WSP(float, WS_RSTD1)};
              pg8::gemm_phase<EpiCols, WinOrder, true, true>(F.lds, g, S, E, F.tid); }
            FRESH();
            { pg8::Gemm g{WSP(bf16, 0), WSP(bf16, 0), 0, 0, D}; PtKvOrder S; S.init(F.G, F.bid, lay == 0 ? DEPTH * 32 : 0);
              EpiPtKv E{EpiPT{WSP(bf16, WS_PT), WSP(float, WS_RSTD1)}, EpiKv{WSP(bf16, WS_KV4)}};
              pg8::gemm_phase<EpiPtKv, PtKvOrder, true, true>(F.lds, g, S, E, F.tid); }
            } SEAM(s0 + 1); }
#if MK_SINGLE
        if (ACTIVE(s0 + 2)) {
#pragma unroll 1
            for (int st = 0; st < 2; ++st) { FRESH(); const bool conv = (st == 0) == ((F.bid & 1) != 0);
                if (conv) { REP(3) { FRESH(); ph_hyconv(F, args, lay); } }
                else { REP(13) { FRESH(); ph_sgu(F, args, lay); } REP(15) { FRESH(); ph_attn(F, lay); } } }
            SEAM(s0 + 3); }
#else
        if (ACTIVE(s0 + 2)) { REP(2) { REP(13) { FRESH(); ph_sgu(F, args, lay); } REP(15) { FRESH(); ph_attn(F, lay); } } SEAM(s0 + 2); }
        if (ACTIVE(s0 + 3)) { REP(3) { FRESH(); ph_hyconv(F, args, lay); } SEAM(s0 + 3); }
#endif
        if (ACTIVE(s0 + 4)) { REP(4) { FRESH(); ph_hygate(F, args, lay); } SEAM(s0 + 4); }
        if (ACTIVE(s0 + 5)) { REP(5) { FRESH();
            pg8::Gemm g{WSP(bf16, WS_BR), WSP(bf16, WS_WBR), 3 * M, 3 * D, BW}; BranchOrder S; S.init(F.G, F.bid);
            EpiBranch E{WSP(unsigned char, WS_G), WSP(bf16, WS_MERGED)};
            pg8::gemm_phase<EpiBranch, BranchOrder, true, true>(F.lds, g, S, E, F.tid);
            } SEAM(s0 + 5); }
        if (ACTIVE(s0 + 6)) { REP(6) { FRESH();
            pg8::Gemm g{WSP(bf16, WS_MERGED), WSP(bf16, WS_WOUT), M, D, D}; pg8::StaticOrder S; S.init(M, D, F.G, F.bid);
            EpiResNorm E{WSP(bf16, WS_H), WSP(float, WS_MSUM)};
            pg8::gemm_phase<EpiResNorm, pg8::StaticOrder, true, true>(F.lds, g, S, E, F.tid);
            } SEAM(s0 + 6); }
        if (ACTIVE(s0 + 7)) { REP(7) { FRESH(); ph_norm2(F, args, lay); } SEAM(s0 + 7); }
        if (ACTIVE(s0 + 8)) { REP(8) { FRESH(); ph_topk(F); }
            SEAM(s0 + 8); }
        if (ACTIVE(s0 + 9)) { REP(9) { FRESH();
            pg8::Gemm g{WSP(bf16, WS_H), WSP(bf16, WS_W13), NE * 4096, NE * 2048, D}; MoeOrder S; S.init(F.G, F.bid, 8);
            EpiMoeUp E{WSP(bf16, WS_HID), WSP(float, WS_RSG)};
            { const unsigned* RMAP = WSP(unsigned, WS_RMAP); LAS unsigned* rt = (LAS unsigned*)(F.lds + ROWTAB_OFF);
              __syncthreads();
              unsigned rq[7];
#pragma unroll
              for (int j = 0; j < 7; ++j) { const int ui = 2 * j + (F.wave >> 2); pg8::Unit u; rq[j] = S.next(ui, u) ? ((const GAS unsigned*)RMAP)[u.pm * 256 + (F.tid & 255)] : 0u; }
#pragma unroll
              for (int j = 0; j < 7; ++j) { const int ui = 2 * j + (F.wave >> 2); rt[ui * 256 + (F.tid & 255)] = rq[j]; }
              __syncthreads(); }
            pg8::gemm_phase<EpiMoeUp, MoeOrder, true, true, true>(F.lds, g, S, E, F.tid, (const LAS unsigned*)(F.lds + ROWTAB_OFF));
            } SEAM(s0 + 9); }
        if (ACTIVE(s0 + 10)) { REP(10) { FRESH();
            pg8::Gemm g{WSP(bf16, WS_HID), WSP(bf16, WS_W2), NE * 4096, NE * 1024, FF}; MoeOrder S; S.init(F.G, F.bid, 4);
            EpiMoeDown E{WSP(bf16, WS_Y), WSP(float, WS_GATE)};
            pg8::gemm_phase<EpiMoeDown, MoeOrder, true, true>(F.lds, g, S, E, F.tid);
            } SEAM(s0 + 10); }
        if (ACTIVE(s0 + 11)) { { FRESH(); ph_combine(F, args, lay); } if (lay + 1 < DEPTH) { REP(12) { FRESH(); ph_prep(F, args, lay + 1); } } SEAM(s0 + 11); }
    }
#undef ACTIVE
#undef SEAM
}

extern "C" void kernel_launch(void* const* d_in, const int* in_sizes, int n_in, void* d_out, int out_size, void* d_ws, size_t ws_size, hipStream_t stream) {
    static int grid = 0;
    if (grid == 0) {
        if (n_in != 30 || out_size != M * D || ws_size < WS_END) { fprintf(stderr, "kernel_launch: unexpected shapes: n_in %d out %d ws %zu (need >= %zu)\n", n_in, out_size, ws_size, (size_t)WS_END); grid = -1; return; }
        int dev = 0, cus = 0;
        if (hipGetDevice(&dev) != hipSuccess || hipDeviceGetAttribute(&cus, hipDeviceAttributeMultiprocessorCount, dev) != hipSuccess) { grid = -1; return; }
        if (hipFuncSetAttribute((const void*)mk_fwd, hipFuncAttributeMaxDynamicSharedMemorySize, LDS_BYTES) != hipSuccess) { fprintf(stderr, "kernel_launch: hipFuncSetAttribute failed\n"); grid = -1; return; }
        int per_cu = 0;
        if (hipOccupancyMaxActiveBlocksPerMultiprocessor(&per_cu, (const void*)mk_fwd, NTHR, LDS_BYTES) != hipSuccess || per_cu < 1) fprintf(stderr, "kernel_launch: occupancy query reports %d\n", per_cu);
        (void)hipGetLastError();
        grid = cus;
    }
    if (grid < 0) return;
    (void)hipMemsetAsync((char*)d_ws + WS_CTL, 0, CTL_ZERO_BYTES, stream);
    Args a{};
    for (int i = 0; i < 30; ++i) a.in[i] = (const float*)d_in[i];
    a.out = (float*)d_out; a.ws = (unsigned char*)d_ws;
#if MK_SINGLE
    a.s_lo = 0; a.s_hi = NSTEP;
    hipLaunchKernelGGL(mk_fwd, dim3(grid), dim3(NTHR), LDS_BYTES, stream, a);
#else
    for (int s = 0; s < NSTEP; ++s) {
        a.s_lo = s; a.s_hi = s + 1;
        hipLaunchKernelGGL(mk_fwd, dim3(grid), dim3(NTHR), LDS_BYTES, stream, a);
    }
#endif
    const hipError_t le = hipPeekAtLastError();
    if (le != hipSuccess) fprintf(stderr, "kernel_launch: launch failed: %s\n", hipGetErrorName(le));
}
```

```cpp
#include <hip/hip_runtime.h>
#include <cstdio>
#include <cstdint>
namespace pg8 {
#define PG8_LAS __attribute__((address_space(3)))
typedef unsigned short bf16_t;
typedef short bf16x8 __attribute__((ext_vector_type(8)));
typedef float f32x4 __attribute__((ext_vector_type(4)));
typedef unsigned u32x4 __attribute__((ext_vector_type(4)));
constexpr int BM = 256, BK = 64, HALF = 128, HTB = HALF * BK * 2  , STAGE_BYTES = 8 * HTB, NXCD = 8, WGM = 8;

__host__ __device__ __forceinline__ int lds_byte(int r, int c) { const int st = (r >> 4) * 2 + (c >> 5), rr = r & 15, cc = c & 31, ob = rr * 64 + cc * 2; return st * 1024 + (ob ^ (((ob >> 9) & 1) << 5)); }
__host__ __device__ __forceinline__ void stage_rc(int b, int& R, int& C) { const int st = b / 1024, sb = b % 1024, swz = sb ^ (((sb >> 9) & 1) << 5); R = (st >> 1) * 16 + swz / 64; C = (st & 1) * 32 + (swz % 64) / 2; }
__host__ __device__ __forceinline__ int perm32(int rho) { const int n = rho >> 4, i = rho & 15; return 8 * (i >> 2) + 4 * n + (i & 3); }

struct Unit { int pm, pn; };
struct Gemm { const bf16_t* A; const bf16_t* Bt; int M, N, K; };

struct StaticOrder {
    int nM, nN, nwg, G, c;
    __host__ __device__ __forceinline__ void init(int M, int N, int G_, int c_) { nM = M / BM; nN = N / BM; nwg = nM * nN; G = G_; c = c_; }
    __host__ __device__ __forceinline__ bool next(int i, Unit& u) const {
        const long L = (long)i * G + c; if (L >= nwg) return false;
        int wgid = (int)L; { const int q = nwg / NXCD, r = nwg % NXCD, xcd = wgid % NXCD, off = wgid / NXCD; wgid = (xcd < r ? xcd * (q + 1) : r * (q + 1) + (xcd - r) * q) + off; }
        const int nig = WGM * nN, gid = wgid / nig, fm = gid * WGM, gsz = (nM - fm) < WGM ? (nM - fm) : WGM;
        u.pm = fm + ((wgid % nig) % gsz); u.pn = (wgid % nig) / gsz; return true;
    }
    __device__ __forceinline__ void a_ready(const Unit&) const {}
    __device__ __forceinline__ void done(const Unit&) const {}
};
__device__ __forceinline__ unsigned cvt_pk_bf16(float lo, float hi) { unsigned r; asm volatile("v_cvt_pk_bf16_f32 %0, %1, %2" : "=v"(r) : "v"(lo), "v"(hi)); return r; }
typedef float f32x2 __attribute__((ext_vector_type(2)));
__device__ __forceinline__ f32x2 gelu_pk(f32x2 v) {
    const f32x2 av = __builtin_elementwise_abs(v), d = av * 0.2316418882f + 1.0f;
    f32x2 t; t.x = __builtin_amdgcn_rcpf(d.x); t.y = __builtin_amdgcn_rcpf(d.y);
    f32x2 q = t * 0.5307027145f + (-0.7265760135f); q = q * t + 0.7107068705f; q = q * t + (-0.142248368f); q = q * t + 0.127414796f; q = q * t;
    const f32x2 s = (v * v) * (-0.72134752044f);
    f32x2 e; e.x = __builtin_amdgcn_exp2f(s.x); e.y = __builtin_amdgcn_exp2f(s.y);
    const f32x2 m = v * (q * e), r = v - m;
    f32x2 o; o.x = v.x < 0.f ? m.x : r.x; o.y = v.y < 0.f ? m.y : r.y; return o;
}
template <class T, class = void> struct epi_has_prefetch { static constexpr bool value = false; };
template <class T> struct epi_has_prefetch<T, decltype((void)&T::prefetch)> { static constexpr bool value = true; };
template <class T, class = void> struct epi_has_carry { static constexpr bool value = false; };
template <class T> struct epi_has_carry<T, decltype((void)&T::carry)> { static constexpr bool value = true; };
template <class T, class = void> struct epi_npre { static constexpr int value = 8; };
template <class T> struct epi_npre<T, decltype((void)T::NPRE)> { static constexpr int value = T::NPRE; };
template <class Epi, class Sched, bool ALIGN_EPI = false, bool SP2 = false, bool GATHER = false>
__device__ __forceinline__ void gemm_phase(PG8_LAS unsigned char* lds, const Gemm g, const Sched& S, const Epi& E, const int tid, const PG8_LAS unsigned* rowtab = nullptr) {
    static_assert(!GATHER || SP2, "gather staging is written for the SP2 loop only");
    const int wid = __builtin_amdgcn_readfirstlane(tid >> 6), lane = tid & 63, wr = wid >> 2, wc = wid & 3, fr = lane & 15, fq = lane >> 4;
    const int K = g.K, nt = K / BK;
    unsigned voffA[2], voffB[2];
#pragma unroll
    for (int i = 0; i < 2; ++i) { int R, C; stage_rc(tid * 16 + i * 8192, R, C); const int Rb = Epi::PERM ? ((R & ~31) + perm32(R & 31)) : R;
        voffA[i] = (unsigned)(R * K + C) * 2u; voffB[i] = (unsigned)(Rb * K + C) * 2u; }
    const size_t kstep = (size_t)(BK * 2);
    const size_t hstep = (size_t)HALF * K * 2;
    const size_t tstep = 2 * hstep;
    const size_t hstepA = GATHER ? (size_t)0 : hstep, tstepA = GATHER ? (size_t)0 : tstep;
    const unsigned ldsw = (unsigned)wid * 1024u;
    const int aoff = lds_byte(wr * 64 + fr, fq * 8), boff = lds_byte(wc * 32 + fr, fq * 8);
#define PG8_SA(b, h) (((b) * 2 + (h)) * HTB)
#define PG8_SB(b, h) ((4 + (b) * 2 + (h)) * HTB)
#define PG8_STAGE(bufoff, gbase, voff) do { _Pragma("unroll") for (int _i = 0; _i < 2; ++_i) \
        __builtin_amdgcn_global_load_lds((const unsigned*)((const char*)(gbase) + (voff)[_i]), (PG8_LAS unsigned*)(lds + (bufoff) + ldsw + _i * 8192), 16, 0, 0); } while (0)
#define PG8_LDA(dst, b, h) do { _Pragma("unroll") for (int m = 0; m < 4; ++m) _Pragma("unroll") for (int k = 0; k < 2; ++k) dst[m][k] = *(const PG8_LAS bf16x8*)(lds + PG8_SA(b, h) + aoff + m * 2048 + k * 1024); } while (0)
#define PG8_LDB(dst, b, h) do { _Pragma("unroll") for (int n = 0; n < 2; ++n) _Pragma("unroll") for (int k = 0; k < 2; ++k) dst[n][k] = *(const PG8_LAS bf16x8*)(lds + PG8_SB(b, h) + boff + n * 2048 + k * 1024); } while (0)
#define PG8_MMA(ai, bj, At, Bt) do { __builtin_amdgcn_s_setprio(1); _Pragma("unroll") for (int m = 0; m < 4; ++m) _Pragma("unroll") for (int n = 0; n < 2; ++n) _Pragma("unroll") for (int k = 0; k < 2; ++k) \
        acc[ai][bj][m][n] = __builtin_amdgcn_mfma_f32_16x16x32_bf16(Bt[n][k], At[m][k], acc[ai][bj][m][n], 0, 0, 0); __builtin_amdgcn_s_setprio(0); } while (0)
#define PG8_WAIT_V(n) asm volatile("s_waitcnt vmcnt(" #n ")" ::: "memory")
#define PG8_WAIT_L(n) asm volatile("s_waitcnt lgkmcnt(" #n ")" ::: "memory")
#define PG8_BAR __builtin_amdgcn_s_barrier()
#define PG8_SCHED __builtin_amdgcn_sched_barrier(0)
    Unit cur, nxt; int ui = 0;
    constexpr int NPRE = epi_npre<Epi>::value; float pre[NPRE];
#pragma unroll
    for (int k = 0; k < NPRE; ++k) pre[k] = 0.f;
    if (!S.next(0, cur)) return;
    f32x4 acc[2][2][4][2];
#pragma unroll
    for (int a = 0; a < 2; ++a)
#pragma unroll
        for (int b = 0; b < 2; ++b)
#pragma unroll
            for (int m = 0; m < 4; ++m)
#pragma unroll
                for (int n = 0; n < 2; ++n) acc[a][b][m][n] = (f32x4){0.f, 0.f, 0.f, 0.f};
    bf16x8 At[4][2], B0[2][2], B1[2][2];
    const char* cA = (const char*)g.A + (size_t)cur.pm * tstepA; const char* cB = (const char*)g.Bt + (size_t)cur.pn * tstep;
    unsigned vA0[2], vA1[2], nA0[2], nA1[2];
#pragma unroll
    for (int i = 0; i < 2; ++i) { if constexpr (GATHER) { int R, C; stage_rc(tid * 16 + i * 8192, R, C); vA0[i] = rowtab[R] + (unsigned)C * 2u; vA1[i] = rowtab[128 + R] + (unsigned)C * 2u; } else { vA0[i] = voffA[i]; vA1[i] = voffA[i]; }
        nA0[i] = vA0[i]; nA1[i] = vA1[i]; }
    S.a_ready(cur);
    if constexpr (SP2) {
        PG8_STAGE(PG8_SB(0, 0), cB, voffB); PG8_STAGE(PG8_SB(0, 1), cB + hstep, voffB); PG8_STAGE(PG8_SA(0, 0), cA, vA0); PG8_STAGE(PG8_SA(0, 1), cA + hstepA, vA1);
        if (wr == 1) PG8_BAR;
        PG8_WAIT_V(2); PG8_BAR;
        PG8_STAGE(PG8_SB(1, 0), cB + kstep, voffB); PG8_STAGE(PG8_SA(1, 0), cA + kstep, vA0); PG8_STAGE(PG8_SB(1, 1), cB + hstep + kstep, voffB);
        PG8_WAIT_V(6); PG8_BAR;
    } else {
        PG8_STAGE(PG8_SB(0, 0), cB, voffB); PG8_STAGE(PG8_SA(0, 0), cA, voffA); PG8_STAGE(PG8_SB(0, 1), cB + hstep, voffB); PG8_STAGE(PG8_SA(0, 1), cA + hstep, voffA);
        if (wr == 1) PG8_BAR;
        PG8_WAIT_V(4); PG8_BAR;
        PG8_STAGE(PG8_SB(1, 0), cB + kstep, voffB); PG8_STAGE(PG8_SA(1, 0), cA + kstep, voffA); PG8_STAGE(PG8_SB(1, 1), cB + hstep + kstep, voffB);
        PG8_WAIT_V(6); PG8_BAR;
    }
    for (;;) {
        const bool has_next = S.next(ui + 1, nxt);
        const char* nA = has_next ? (const char*)g.A + (size_t)nxt.pm * tstepA : cA; const char* nB = has_next ? (const char*)g.Bt + (size_t)nxt.pn * tstep : cB;
        for (int t = 0; t < nt; t += 2) {
            const bool last = (t == nt - 2);
            const char* a1 = cA + (size_t)(t + 1) * kstep;
            const char* a2 = last ? nA : cA + (size_t)(t + 2) * kstep; const char* b2 = last ? nB : cB + (size_t)(t + 2) * kstep;
            const char* a3 = a2 + kstep; const char* b3 = b2 + kstep;
            if (last && has_next) S.a_ready(nxt);
            if constexpr (epi_has_prefetch<Epi>::value) { if (last) E.prefetch(cur, wr, wc, fr, fq, pre); }
            if constexpr (GATHER) { if (last && has_next) {
#pragma unroll
                for (int i = 0; i < 2; ++i) { int R, C; stage_rc(tid * 16 + i * 8192, R, C); nA0[i] = rowtab[(ui + 1) * 256 + R] + (unsigned)C * 2u; nA1[i] = rowtab[(ui + 1) * 256 + 128 + R] + (unsigned)C * 2u; } } }
            unsigned wA0[2], wA1[2];
#pragma unroll
            for (int i = 0; i < 2; ++i) { wA0[i] = (GATHER && last) ? nA0[i] : vA0[i]; wA1[i] = (GATHER && last) ? nA1[i] : vA1[i]; }
            if constexpr (SP2) {
            PG8_LDB(B0, 0, 0); PG8_LDB(B1, 0, 1); PG8_SCHED; PG8_LDA(At, 0, 0); PG8_STAGE(PG8_SA(1, 1), a1 + hstepA, vA1);
            PG8_WAIT_V(8); PG8_WAIT_L(0); PG8_BAR; PG8_MMA(0, 0, At, B0); PG8_MMA(0, 1, At, B1); PG8_BAR; PG8_SCHED;
            PG8_LDA(At, 0, 1); PG8_STAGE(PG8_SB(0, 0), b2, voffB); PG8_STAGE(PG8_SB(0, 1), b2 + hstep, voffB); PG8_STAGE(PG8_SA(0, 0), a2, wA0);
            PG8_WAIT_V(8); PG8_WAIT_L(0); PG8_BAR; PG8_MMA(1, 0, At, B0); PG8_MMA(1, 1, At, B1); PG8_BAR; PG8_SCHED;
            PG8_LDB(B0, 1, 0); PG8_LDB(B1, 1, 1); PG8_SCHED; PG8_LDA(At, 1, 0); PG8_STAGE(PG8_SA(0, 1), a2 + hstepA, wA1);
            PG8_WAIT_V(8); PG8_WAIT_L(0); PG8_BAR; PG8_MMA(0, 0, At, B0); PG8_MMA(0, 1, At, B1); PG8_BAR; PG8_SCHED;
            PG8_LDA(At, 1, 1); PG8_STAGE(PG8_SB(1, 0), b3, voffB); PG8_STAGE(PG8_SB(1, 1), b3 + hstep, voffB); PG8_STAGE(PG8_SA(1, 0), a3, wA0);
            PG8_WAIT_V(8); PG8_WAIT_L(0); PG8_BAR; PG8_MMA(1, 0, At, B0); PG8_MMA(1, 1, At, B1); PG8_BAR; PG8_SCHED;
            } else {
            PG8_LDB(B0, 0, 0); PG8_SCHED; PG8_LDA(At, 0, 0); PG8_STAGE(PG8_SA(1, 1), a1 + hstep, voffA);
            PG8_WAIT_L(8); PG8_BAR; PG8_WAIT_L(0); PG8_MMA(0, 0, At, B0); PG8_BAR; PG8_SCHED;
            PG8_LDB(B1, 0, 1); PG8_STAGE(PG8_SB(0, 0), b2, voffB);
            PG8_BAR; PG8_WAIT_L(0); PG8_MMA(0, 1, At, B1); PG8_BAR;
            PG8_LDA(At, 0, 1); PG8_STAGE(PG8_SA(0, 0), a2, voffA);
            PG8_BAR; PG8_WAIT_L(0); PG8_MMA(1, 0, At, B0); PG8_BAR; PG8_SCHED;
            PG8_STAGE(PG8_SB(0, 1), b2 + hstep, voffB);
            PG8_WAIT_V(6); PG8_BAR; PG8_MMA(1, 1, At, B1); PG8_BAR;
            PG8_LDB(B0, 1, 0); PG8_SCHED; PG8_LDA(At, 1, 0); PG8_STAGE(PG8_SA(0, 1), a2 + hstep, voffA);
            PG8_WAIT_L(8); PG8_BAR; PG8_WAIT_L(0); PG8_MMA(0, 0, At, B0); PG8_BAR; PG8_SCHED;
            PG8_LDB(B1, 1, 1); PG8_STAGE(PG8_SB(1, 0), b3, voffB);
            PG8_BAR; PG8_WAIT_L(0); PG8_MMA(0, 1, At, B1); PG8_BAR;
            PG8_LDA(At, 1, 1); PG8_STAGE(PG8_SA(1, 0), a3, voffA);
            PG8_BAR; PG8_WAIT_L(0); PG8_MMA(1, 0, At, B0); PG8_BAR; PG8_SCHED;
            PG8_STAGE(PG8_SB(1, 1), b3 + hstep, voffB);
            PG8_WAIT_V(6); PG8_BAR; PG8_MMA(1, 1, At, B1); PG8_BAR;
            }
        }
        if constexpr (ALIGN_EPI) { if (wr == 0) PG8_BAR; }
        if constexpr (!Epi::AFTER_DRAIN) { if constexpr (epi_has_prefetch<Epi>::value) E(acc, cur, wr, wc, fr, fq, pre); else E(acc, cur, wr, wc, fr, fq); S.done(cur); }
        if (!has_next) break;
        bool keep_acc = false;
        if constexpr (epi_has_carry<Epi>::value) keep_acc = E.carry(cur);
        if (!keep_acc) {
#pragma unroll
        for (int a = 0; a < 2; ++a)
#pragma unroll
            for (int b = 0; b < 2; ++b)
#pragma unroll
                for (int m = 0; m < 4; ++m)
#pragma unroll
                    for (int n = 0; n < 2; ++n) acc[a][b][m][n] = (f32x4){0.f, 0.f, 0.f, 0.f};
        }
        cur = nxt; cA = nA; cB = nB; ++ui;
#pragma unroll
        for (int i = 0; i < 2; ++i) { vA0[i] = nA0[i]; vA1[i] = nA1[i]; }
        if constexpr (ALIGN_EPI) { if (wr == 1) PG8_BAR; }
    }
    PG8_WAIT_V(0);
    if constexpr (!ALIGN_EPI) { if (wr == 0) PG8_BAR; }
    PG8_BAR;
    if constexpr (Epi::AFTER_DRAIN) { E.fused(acc, cur, wr, wc, fr, fq, lds, wid, lane); S.done(cur); }
#undef PG8_SA
#undef PG8_SB
#undef PG8_STAGE
#undef PG8_LDA
#undef PG8_LDB
#undef PG8_MMA
#undef PG8_WAIT_V
#undef PG8_WAIT_L
#undef PG8_BAR
#undef PG8_SCHED
}
}
namespace attn {
typedef unsigned short bf16;
constexpr int   D = 128, NW = 8, QBLK = 32, KVBLK = 64;
constexpr float SCALE = 0.088388347648318440f;
constexpr float THR = 8.f;
constexpr int SDEPTH = 2;
constexpr int LDQ = 512, LDK = 1024, LDO = 512;
constexpr size_t SHM_V = KVBLK * D * 2, SHM_K = KVBLK * D * 2, SHM_ATTN = 2 * SHM_V + 2 * SHM_K + NW * 64 * 4;
using bf16x8 = __attribute__((ext_vector_type(8))) short;
using s16x4  = __attribute__((ext_vector_type(4))) short;
using f32x16 = __attribute__((ext_vector_type(16))) float;
using f32x8  = __attribute__((ext_vector_type(8))) float;
using u32x4  = __attribute__((ext_vector_type(4))) unsigned;
#define KSWZ(row, colB) ((row) * 256 + ((colB) ^ (((row) & 7) << 4)))
#define SBAR() __builtin_amdgcn_sched_barrier(0)
__device__ __forceinline__ int crow(int r, int hi) { return (r & 3) + 8 * (r >> 2) + 4 * hi; }
__device__ __forceinline__ unsigned cvtpk(float lo, float hi) {
  unsigned r; asm volatile("v_cvt_pk_bf16_f32 %0, %1, %2" : "=v"(r) : "v"(lo), "v"(hi)); return r;
}
template <typename TIn> struct Stage;
template <> struct Stage<bf16>  { using T = bf16x8;
  __device__ static __forceinline__ T ld8(const bf16* p) { return *reinterpret_cast<const bf16x8*>(p); }
  __device__ static __forceinline__ bf16x8 tobf(T x) { return x; } };

__device__ __forceinline__ void partialSM(f32x16& p0, f32x16& p1, float& m_reg, float& mn, float& alpha) {
  constexpr float C = SCALE * 1.4426950408889634f;
  float pmax = p0[0]; for (int r = 1; r < 16; ++r) pmax = fmaxf(pmax, p0[r]); for (int r = 0; r < 16; ++r) pmax = fmaxf(pmax, p1[r]);
  { auto rr = __builtin_amdgcn_permlane32_swap(__float_as_uint(pmax), __float_as_uint(pmax), false, false);
    pmax = fmaxf(__uint_as_float(rr[0]), __uint_as_float(rr[1])); }
  if (__builtin_expect(__all(pmax - m_reg <= THR / SCALE), 1)) { mn = m_reg; alpha = 1.f; }
  else { mn = fmaxf(m_reg, pmax); alpha = __builtin_amdgcn_exp2f((m_reg - mn) * C); m_reg = mn; }
  float mnC = -mn * C;
  for (int r = 0; r < 16; ++r) p0[r] = fmaf(p0[r], C, mnC); for (int r = 0; r < 16; ++r) p1[r] = fmaf(p1[r], C, mnC);
  for (int r = 0; r < 16; ++r) p0[r] = __builtin_amdgcn_exp2f(p0[r]);
}
__device__ __forceinline__ void finishSM(f32x16& p0, f32x16& p1, float alpha, float& l_reg, bf16x8& pa0, bf16x8& pa1, bf16x8& pa2, bf16x8& pa3) {
  for (int r = 0; r < 16; ++r) p1[r] = __builtin_amdgcn_exp2f(p1[r]);
  float ps = 0; for (int r = 0; r < 16; ++r) ps += p0[r]; for (int r = 0; r < 16; ++r) ps += p1[r];
  { auto rr = __builtin_amdgcn_permlane32_swap(__float_as_uint(ps), __float_as_uint(ps), false, false);
    ps = __uint_as_float(rr[0]) + __uint_as_float(rr[1]); }
  l_reg = l_reg * alpha + ps;
#define PK4(P, BASE, OUT) do { unsigned a0 = cvtpk(P[BASE + 0], P[BASE + 1]), a1 = cvtpk(P[BASE + 2], P[BASE + 3]);   \
    unsigned b0 = cvtpk(P[BASE + 4], P[BASE + 5]), b1 = cvtpk(P[BASE + 6], P[BASE + 7]);                              \
    auto r0 = __builtin_amdgcn_permlane32_swap(a0, b0, false, false); auto r1 = __builtin_amdgcn_permlane32_swap(a1, b1, false, false); \
    u32x4 w = {r0[0], r1[0], r0[1], r1[1]}; OUT = *reinterpret_cast<bf16x8*>(&w); } while (0)
  PK4(p0, 0, pa0); PK4(p0, 8, pa1); PK4(p1, 0, pa2); PK4(p1, 8, pa3);
#undef PK4
}
__device__ __forceinline__ void qkt(f32x16& p0, f32x16& p1, const bf16* Ks, const bf16x8* qr, int r32, int hi) {
  p0 = f32x16{}; p1 = f32x16{};
  for (int d0 = 0; d0 < 8; ++d0) { int cb = (d0 * 16 + hi * 8) * 2;
    bf16x8 b0 = *reinterpret_cast<const bf16x8*>((const char*)Ks + KSWZ(r32, cb));
    bf16x8 b1 = *reinterpret_cast<const bf16x8*>((const char*)Ks + KSWZ(32 + r32, cb));
    p0 = __builtin_amdgcn_mfma_f32_32x32x16_bf16(b0, qr[d0], p0, 0, 0, 0);
    p1 = __builtin_amdgcn_mfma_f32_32x32x16_bf16(b1, qr[d0], p1, 0, 0, 0); }
}
__device__ __forceinline__ int v_st(int k, int c) { const int kk = (k & ~0xC) | ((k & 4) << 1) | ((k & 8) >> 1); return ((kk >> 3) * 4 + (c >> 5)) * 512 + ((kk & 7) * 32 + (c & 31)) * 2; }
__device__ __forceinline__ int v_rd_base(int lane) { return ((lane & 3) << 3) | (((lane >> 2) & 3) << 6) | (((lane >> 4) & 1) << 5) | (((lane >> 5) & 1) << 8); }
constexpr int v_rd_off(int d0, int ks, int half) { return d0 * 512 + ks * 4096 + half * 2048; }
template <int OFF> __device__ __forceinline__ s16x4 tr_read(int vb) {
  s16x4 r; asm volatile("ds_read_b64_tr_b16 %0, %1 offset:%2" : "=&v"(r) : "v"(vb), "i"(OFF) : "memory"); return r;
}
template <int D0> __device__ __forceinline__ void pv_one(f32x16& od, int vb, bf16x8 pa0, bf16x8 pa1, bf16x8 pa2, bf16x8 pa3) {
  const s16x4 l0 = tr_read<v_rd_off(D0, 0, 0)>(vb), h0 = tr_read<v_rd_off(D0, 0, 1)>(vb), l1 = tr_read<v_rd_off(D0, 1, 0)>(vb), h1 = tr_read<v_rd_off(D0, 1, 1)>(vb);
  const s16x4 l2 = tr_read<v_rd_off(D0, 2, 0)>(vb), h2 = tr_read<v_rd_off(D0, 2, 1)>(vb), l3 = tr_read<v_rd_off(D0, 3, 0)>(vb), h3 = tr_read<v_rd_off(D0, 3, 1)>(vb);
  asm volatile("s_waitcnt lgkmcnt(0)" ::: "memory"); SBAR();
#define PK(L, H) (bf16x8){L[0], L[1], L[2], L[3], H[0], H[1], H[2], H[3]}
  od = __builtin_amdgcn_mfma_f32_32x32x16_bf16(pa0, PK(l0, h0), od, 0, 0, 0);
  od = __builtin_amdgcn_mfma_f32_32x32x16_bf16(pa1, PK(l1, h1), od, 0, 0, 0);
  od = __builtin_amdgcn_mfma_f32_32x32x16_bf16(pa2, PK(l2, h2), od, 0, 0, 0);
  od = __builtin_amdgcn_mfma_f32_32x32x16_bf16(pa3, PK(l3, h3), od, 0, 0, 0);
#undef PK
}
__device__ __forceinline__ void pv_d0(f32x16* o, int vb, bf16x8 pa0, bf16x8 pa1, bf16x8 pa2, bf16x8 pa3) {
  pv_one<0>(o[0], vb, pa0, pa1, pa2, pa3); pv_one<1>(o[1], vb, pa0, pa1, pa2, pa3); pv_one<2>(o[2], vb, pa0, pa1, pa2, pa3); pv_one<3>(o[3], vb, pa0, pa1, pa2, pa3);
}

template <int D0> __device__ __forceinline__ void pv_one_t(f32x16& od, int vb, bf16x8 pa0, bf16x8 pa1, bf16x8 pa2, bf16x8 pa3) {
  const s16x4 l0 = tr_read<v_rd_off(D0, 0, 0)>(vb), h0 = tr_read<v_rd_off(D0, 0, 1)>(vb), l1 = tr_read<v_rd_off(D0, 1, 0)>(vb), h1 = tr_read<v_rd_off(D0, 1, 1)>(vb);
  const s16x4 l2 = tr_read<v_rd_off(D0, 2, 0)>(vb), h2 = tr_read<v_rd_off(D0, 2, 1)>(vb), l3 = tr_read<v_rd_off(D0, 3, 0)>(vb), h3 = tr_read<v_rd_off(D0, 3, 1)>(vb);
  asm volatile("s_waitcnt lgkmcnt(0)" ::: "memory"); SBAR();
#define PK(L, H) (bf16x8){L[0], L[1], L[2], L[3], H[0], H[1], H[2], H[3]}
  od = __builtin_amdgcn_mfma_f32_32x32x16_bf16(PK(l0, h0), pa0, od, 0, 0, 0);
  od = __builtin_amdgcn_mfma_f32_32x32x16_bf16(PK(l1, h1), pa1, od, 0, 0, 0);
  od = __builtin_amdgcn_mfma_f32_32x32x16_bf16(PK(l2, h2), pa2, od, 0, 0, 0);
  od = __builtin_amdgcn_mfma_f32_32x32x16_bf16(PK(l3, h3), pa3, od, 0, 0, 0);
#undef PK
}
__device__ __forceinline__ void pv_d0_t(f32x16* o, int vb, bf16x8 pa0, bf16x8 pa1, bf16x8 pa2, bf16x8 pa3) {
  pv_one_t<0>(o[0], vb, pa0, pa1, pa2, pa3); pv_one_t<1>(o[1], vb, pa0, pa1, pa2, pa3); pv_one_t<2>(o[2], vb, pa0, pa1, pa2, pa3); pv_one_t<3>(o[3], vb, pa0, pa1, pa2, pa3);
}

template <typename TQ>
__device__ __forceinline__ void attn_dense_body(const TQ* __restrict__ Qb, const bf16* __restrict__ Kh, const bf16* __restrict__ Vh,
                                                bf16* __restrict__ Ob, int seq, char* lds, const int tid) {
  using St = Stage<bf16>; using SQ = Stage<TQ>;
  const int wid = tid >> 6, lane = tid & 63, r32 = lane & 31, hi = lane >> 5;
  bf16* V_lds = (bf16*)lds; bf16* K_lds = (bf16*)(lds + 2 * SHM_V);
  float* ws = (float*)(lds + 2 * SHM_V + 2 * SHM_K) + wid * 64; float* li_l = ws; float* al_l = ws + 32;
  float m_reg = -1e30f, l_reg = 0; f32x16 o[4] = {}; bf16x8 qr[8];
  const TQ* Qw = Qb + (long)(wid * QBLK + r32) * LDQ + hi * 8;
#pragma unroll
  for (int d0 = 0; d0 < 8; ++d0) qr[d0] = SQ::tobf(SQ::ld8(Qw + d0 * 16));
  const int sr = tid >> 4, sc = (tid & 15) * 8, vst0 = v_st(sr, sc), vst1 = v_st(32 + sr, sc);
  const int vb0 = (int)(uintptr_t)V_lds + v_rd_base(lane);
  struct { typename St::T vs0, vs1, ks0, ks1; } sr_[SDEPTH];
#define SLOAD(i, k0) do { sr_[i].vs0 = St::ld8(&Vh[(long)((k0) + sr) * LDK + sc]); sr_[i].vs1 = St::ld8(&Vh[(long)((k0) + 32 + sr) * LDK + sc]); \
    sr_[i].ks0 = St::ld8(&Kh[(long)((k0) + sr) * LDK + sc]); sr_[i].ks1 = St::ld8(&Kh[(long)((k0) + 32 + sr) * LDK + sc]); } while (0)
#define SWRITE(b, i) do { *(bf16x8*)((char*)V_lds + (b) * SHM_V + vst0) = St::tobf(sr_[i].vs0);          \
    *(bf16x8*)((char*)V_lds + (b) * SHM_V + vst1) = St::tobf(sr_[i].vs1); int kc = sc * 2;               \
    *(bf16x8*)((char*)K_lds + (b) * SHM_K + KSWZ(sr, kc)) = St::tobf(sr_[i].ks0);                       \
    *(bf16x8*)((char*)K_lds + (b) * SHM_K + KSWZ(32 + sr, kc)) = St::tobf(sr_[i].ks1); } while (0)
#define SWAIT() do { if constexpr (SDEPTH == 2) asm volatile("s_waitcnt vmcnt(4)" ::: "memory"); else asm volatile("s_waitcnt vmcnt(0)" ::: "memory"); } while (0)
#define RESC(a) do { if (__any((a) < 1.f)) { if (hi == 0) al_l[r32] = (a); asm volatile("s_waitcnt lgkmcnt(0)" ::: "memory"); \
    for (int d = 0; d < 4; ++d) for (int r = 0; r < 16; ++r) o[d][r] *= al_l[crow(r, hi)]; } } while (0)
  f32x16 pA0, pA1, pB0, pB1; float mnA, mnB, alA, alB; bf16x8 pa0, pa1, pa2, pa3; const int NT = seq / KVBLK;
  constexpr int SE = 0, SO = SDEPTH - 1;
  SLOAD(SE, 0); asm volatile("s_waitcnt vmcnt(0)" ::: "memory"); SWRITE(0, SE); __syncthreads();
  qkt(pA0, pA1, K_lds, qr, r32, hi); partialSM(pA0, pA1, m_reg, mnA, alA);
  SLOAD(SO, KVBLK); if constexpr (SDEPTH == 2) { if (2 < NT) SLOAD(SE, 2 * KVBLK); }
  SWAIT(); SWRITE(1, SO); __syncthreads();
  for (int j = 1; j + 1 < NT; j += 2) {
    SBAR(); qkt(pB0, pB1, (bf16*)((char*)K_lds + SHM_K), qr, r32, hi);
    finishSM(pA0, pA1, alA, l_reg, pa0, pa1, pa2, pa3); SBAR();
    SLOAD(SO, (j + SDEPTH) * KVBLK); SBAR();
    pv_d0(o, vb0, pa0, pa1, pa2, pa3); partialSM(pB0, pB1, m_reg, mnB, alB);
    __syncthreads(); SWAIT(); SWRITE(0, SE);
    RESC(alB); __syncthreads();
    SBAR(); qkt(pA0, pA1, K_lds, qr, r32, hi);
    finishSM(pB0, pB1, alB, l_reg, pa0, pa1, pa2, pa3); SBAR();
    if (SDEPTH == 1 || j + 3 < NT) SLOAD(SE, (j + 1 + SDEPTH) * KVBLK); SBAR();
    pv_d0(o, vb0 + (int)SHM_V, pa0, pa1, pa2, pa3); partialSM(pA0, pA1, m_reg, mnA, alA);
    __syncthreads(); SWAIT(); SWRITE(1, SO);
    RESC(alA); __syncthreads();
  }
  SBAR(); qkt(pB0, pB1, (bf16*)((char*)K_lds + SHM_K), qr, r32, hi);
  finishSM(pA0, pA1, alA, l_reg, pa0, pa1, pa2, pa3); SBAR();
  pv_d0(o, vb0, pa0, pa1, pa2, pa3); partialSM(pB0, pB1, m_reg, mnB, alB);
  __syncthreads(); RESC(alB);
  finishSM(pB0, pB1, alB, l_reg, pa0, pa1, pa2, pa3); SBAR();
  pv_d0(o, vb0 + (int)SHM_V, pa0, pa1, pa2, pa3);
  if (hi == 0) li_l[r32] = l_reg; asm volatile("s_waitcnt lgkmcnt(0)" ::: "memory");
  float rli[16];
#pragma unroll
  for (int r = 0; r < 16; ++r) rli[r] = __builtin_amdgcn_rcpf(li_l[crow(r, hi)]);
  bf16* Ow = Ob + (long)(wid * QBLK) * LDO;
#pragma unroll
  for (int r = 0; r < 16; ++r) { int orow = crow(r, hi);
    for (int d0 = 0; d0 < 4; ++d0) Ow[(long)orow * LDO + d0 * 32 + r32] = (bf16)(cvtpk(o[d0][r] * rli[r], 0.f) & 0xffffu); }
#undef SLOAD
#undef SWRITE
#undef SWAIT
#undef RESC
}

template <int NQB>
__device__ __forceinline__ void attn_resident(const bf16* __restrict__ Qb, const bf16* __restrict__ Kh, const bf16* __restrict__ Vh, bf16* __restrict__ Ob, char* lds, const int tid) {
  using St = Stage<bf16>;
  const int wid = tid >> 6, lane = tid & 63, r32 = lane & 31, hi = lane >> 5;
  bf16* V_lds = (bf16*)lds; bf16* K_lds = (bf16*)(lds + 4 * SHM_V);
  float* ws = (float*)(lds + 4 * SHM_V + 4 * SHM_K) + wid * 64; float* li_l = ws; float* al_l = ws + 32;
  { const int sr = tid >> 4, sc = (tid & 15) * 8, vst0 = v_st(sr, sc), vst1 = v_st(32 + sr, sc), kc = sc * 2;
    bf16x8 kv[4][4];
#pragma unroll
    for (int j = 0; j < 4; ++j) { kv[j][0] = St::ld8(&Vh[(long)(64 * j + sr) * LDK + sc]); kv[j][1] = St::ld8(&Vh[(long)(64 * j + 32 + sr) * LDK + sc]);
      kv[j][2] = St::ld8(&Kh[(long)(64 * j + sr) * LDK + sc]); kv[j][3] = St::ld8(&Kh[(long)(64 * j + 32 + sr) * LDK + sc]); }
#pragma unroll
    for (int j = 0; j < 4; ++j) { *(bf16x8*)((char*)V_lds + j * SHM_V + vst0) = kv[j][0]; *(bf16x8*)((char*)V_lds + j * SHM_V + vst1) = kv[j][1];
      *(bf16x8*)((char*)K_lds + j * SHM_K + KSWZ(sr, kc)) = kv[j][2]; *(bf16x8*)((char*)K_lds + j * SHM_K + KSWZ(32 + sr, kc)) = kv[j][3]; } }
  __syncthreads();
  const int vb0 = (int)(uintptr_t)V_lds + v_rd_base(lane);
#pragma unroll 1
  for (int qb = 0; qb < NQB; ++qb) {
    const bf16* Qw = Qb + (long)(qb * (QBLK * NW) + wid * QBLK + r32) * LDQ + hi * 8;
    bf16x8 qr[8];
#pragma unroll
    for (int d0 = 0; d0 < 8; ++d0) qr[d0] = St::ld8(Qw + d0 * 16);
    float m_reg = -1e30f, l_reg = 0; f32x16 o[4] = {};
#pragma unroll
    for (int j = 0; j < 4; ++j) { f32x16 p0, p1; float mn, al; bf16x8 pa0, pa1, pa2, pa3;
      qkt(p0, p1, (const bf16*)((const char*)K_lds + j * SHM_K), qr, r32, hi); partialSM(p0, p1, m_reg, mn, al);
      if (__any(al < 1.f)) { if (hi == 0) al_l[r32] = al; asm volatile("s_waitcnt lgkmcnt(0)" ::: "memory"); const float ar = al_l[r32];
        for (int d = 0; d < 4; ++d) for (int r = 0; r < 16; ++r) o[d][r] *= ar; }
      finishSM(p0, p1, al, l_reg, pa0, pa1, pa2, pa3); SBAR();
      pv_d0_t(o, vb0 + j * (int)SHM_V, pa0, pa1, pa2, pa3); }
    if (hi == 0) li_l[r32] = l_reg; asm volatile("s_waitcnt lgkmcnt(0)" ::: "memory");
    const float rl = __builtin_amdgcn_rcpf(li_l[r32]);
    bf16* Ow = Ob + (long)(qb * (QBLK * NW) + wid * QBLK + r32) * LDO + 8 * hi;
    typedef unsigned u32x4_ __attribute__((ext_vector_type(4)));
#pragma unroll
    for (int d0 = 0; d0 < 4; ++d0)
#pragma unroll
      for (int q = 0; q < 2; ++q) { const int ja = 8 * q, jb = 8 * q + 4;
        const unsigned a0 = cvtpk(o[d0][ja] * rl, o[d0][ja + 1] * rl), a1 = cvtpk(o[d0][ja + 2] * rl, o[d0][ja + 3] * rl), b0 = cvtpk(o[d0][jb] * rl, o[d0][jb + 1] * rl), b1 = cvtpk(o[d0][jb + 2] * rl, o[d0][jb + 3] * rl);
        auto s0_ = __builtin_amdgcn_permlane32_swap(a0, b0, false, false); auto s1_ = __builtin_amdgcn_permlane32_swap(a1, b1, false, false);
        const u32x4_ w4 = {s0_[0], s1_[0], s0_[1], s1_[1]};
        *(__attribute__((address_space(1))) u32x4_*)(Ow + d0 * 32 + 16 * q) = w4; }
    asm volatile("s_waitcnt lgkmcnt(0)" ::: "memory");
  }
}

}
#ifndef MK_SINGLE
#define MK_SINGLE 1
#endif
constexpr int NWAVES = 8, NTHR = 512;
constexpr int D = 1024, NB = 8, L = 4096, M = NB * L, DEPTH = 4, MEML = 256, MM = NB * MEML;
constexpr int INC = 6144, NE = 16, CAP = 512, FF = 1024, BW = 512;
constexpr int NPH = 12;
constexpr int NSTEP = DEPTH * NPH;

constexpr size_t MiB = 1u << 20;
constexpr size_t WS_CTL = 0, CTL_ZERO_BYTES = 1 * MiB;
constexpr size_t WS_WIN = 1 * MiB, WS_WKV = 13 * MiB, WS_WBR = 15 * MiB, WS_WOUT = 18 * MiB, WS_W13 = 20 * MiB, WS_W2 = 84 * MiB;
constexpr size_t WS_H = 116 * MiB, WS_MEMN = 180 * MiB, WS_KV = 184 * MiB, WS_FILT = 188 * MiB, WS_AFF = 204 * MiB, WS_IDX = 206 * MiB, WS_GATE = 207 * MiB;
constexpr size_t WS_UV = 208 * MiB, WS_P = 272 * MiB, WS_Q = 368 * MiB, WS_G = 400 * MiB, WS_BR = 592 * MiB, WS_MSUM = 688 * MiB, WS_MERGED = 816 * MiB, WS_U = 880 * MiB;
constexpr size_t WS_XIN = WS_UV, WS_HID = WS_G;
constexpr size_t WS_UT = WS_U, WS_YT = WS_U + 32 * MiB;
constexpr size_t WS_RSTD1 = WS_GATE + 256 * 1024, WS_RSTD2 = WS_GATE + 384 * 1024, WS_RSG = WS_GATE + 512 * 1024;
constexpr size_t WS_RMAP = WS_IDX + 256 * 1024;
constexpr size_t WS_WSB = WS_IDX + 512 * 1024;
constexpr size_t WS_INV = 944 * MiB, WS_Y = WS_UV;
constexpr size_t WS_MEMN4 = 946 * MiB, WS_KV4 = 962 * MiB, WS_WKV4 = 978 * MiB;
constexpr size_t WS_PT = WS_P;
constexpr int PTS = M;
constexpr size_t WS_END = 986 * MiB;
constexpr int CW_BAR = 4096;

constexpr int ROWTAB_OFF = 131072;
constexpr int RING_BYTES = 131072, LDS_BYTES = 147456, LDSCTL_OFF = LDS_BYTES - 1024, MISC_OFF = LDSCTL_OFF + 320;

#define GAS __attribute__((address_space(1)))
#define LAS __attribute__((address_space(3)))
typedef unsigned short bf16;
typedef unsigned v4u __attribute__((ext_vector_type(4)));
typedef unsigned v2u __attribute__((ext_vector_type(2)));
typedef float f32x4 __attribute__((ext_vector_type(4)));
typedef float f32x2 __attribute__((ext_vector_type(2)));
#define LDS_WAIT() asm volatile("s_waitcnt lgkmcnt(0)" ::: "memory")
#define VM_WAIT() asm volatile("s_waitcnt vmcnt(0)" ::: "memory")
__device__ __forceinline__ unsigned f2bf(float f) { unsigned u = __builtin_bit_cast(unsigned, f); return (u + 0x7fffu + ((u >> 16) & 1u)) >> 16; }
__device__ __forceinline__ unsigned pk2(float lo, float hi) { return f2bf(lo) | (f2bf(hi) << 16); }
__device__ __forceinline__ float bflo(unsigned w) { return __builtin_bit_cast(float, w << 16); }
__device__ __forceinline__ float bfhi(unsigned w) { return __builtin_bit_cast(float, w & 0xffff0000u); }
__device__ __forceinline__ float bf2f(bf16 b) { return __builtin_bit_cast(float, ((unsigned)b) << 16); }
__device__ __forceinline__ float wave_sum(float v, int lane) {
#pragma unroll
    for (int o = 1; o < 64; o <<= 1) v += __builtin_bit_cast(float, __builtin_amdgcn_ds_bpermute((lane ^ o) << 2, __builtin_bit_cast(int, v)));
    return v;
}
__device__ __forceinline__ float sin_turns(float t) { t -= floorf(t); return __builtin_amdgcn_sinf(t); }
__device__ __forceinline__ float cos_turns(float t) { t -= floorf(t); return __builtin_amdgcn_cosf(t); }
__device__ __forceinline__ float sin_rad(float x) { return sin_turns(x * 0.15915494309189535f); }
__device__ __forceinline__ float sigmoidf_(float v) { return __builtin_amdgcn_rcpf(1.0f + __builtin_amdgcn_exp2f(-1.4426950408889634f * v)); }

#define XB_TMO      128
#define XB_XCNT(j)  (256  + 64 * (j))
#define XB_XSUB(j)  (1280 + 64 * (j))
#define XB_XGEN(j)  (2304 + 64 * (j))
#define XB_TOP      3328
#define XB_TOPGEN   3392
#define XCD_BAR_WORDS 3456
#define XB_SPIN_CAP (1u << 18)

__device__ __forceinline__ unsigned xb_ld(unsigned* p)              { return __hip_atomic_load(p, __ATOMIC_RELAXED, __HIP_MEMORY_SCOPE_AGENT); }
__device__ __forceinline__ unsigned xb_add(unsigned* p, unsigned v) { return __hip_atomic_fetch_add(p, v, __ATOMIC_RELAXED, __HIP_MEMORY_SCOPE_AGENT); }
__device__ __forceinline__ unsigned xb_xcc_id() { return (unsigned)__builtin_amdgcn_s_getreg((3 << 11) | 20) & 0xFu; }
#define XB_SPIN(cond, bar) do { unsigned _sp = 0; while (cond) { __builtin_amdgcn_s_sleep(1); \
    if ((++_sp & 255u) == 0u) { if (xb_ld(&(bar)[XB_TMO])) break; if (_sp > XB_SPIN_CAP) { atomicAdd(&(bar)[XB_TMO], 1u); break; } } } } while (0)

struct XcdBarrier {
    unsigned* bar; unsigned x;
    volatile LAS unsigned* st;
};

__device__ __forceinline__ XcdBarrier xcd_barrier_post(unsigned* bar, volatile LAS unsigned* st) {
    XcdBarrier b; b.bar = bar; b.x = xb_xcc_id(); b.st = st;
    if (threadIdx.x == 0) (void)xb_add(&bar[XB_XCNT(b.x)], 1u);
    return b;
}
__device__ __forceinline__ void xcd_barrier_complete(unsigned* bar, unsigned x, unsigned& nloc, unsigned& nx) {
    const unsigned G = gridDim.x * gridDim.y * gridDim.z;
    unsigned sum, cnt, mine, sp = 0u;
    for (;;) {
        sum = 0u; cnt = 0u; mine = 0u;
#pragma unroll
        for (unsigned j = 0; j < 16; ++j) { const unsigned c = xb_ld(&bar[XB_XCNT(j)]); sum += c; cnt += (c > 0u) ? 1u : 0u; mine = (j == x) ? c : mine; }
        if (sum == G) break;
        __builtin_amdgcn_s_sleep(1);
        if ((++sp & 255u) == 0u) { if (xb_ld(&bar[XB_TMO])) break; if (sp > XB_SPIN_CAP) { atomicAdd(&bar[XB_TMO], 1u); break; } }
    }
    nloc = mine > 0u ? mine : 1u; nx = cnt > 0u ? cnt : 1u;
}

__device__ __forceinline__ void xcd_barrier(const XcdBarrier& b) {
    asm volatile("s_waitcnt vmcnt(0)" ::: "memory");
    __syncthreads();
    if (threadIdx.x == 0) {
        unsigned* bar = b.bar;
        __builtin_amdgcn_s_waitcnt(0);
        unsigned nloc = b.st[0], nx = b.st[1];
        if (nloc == 0u) { xcd_barrier_complete(bar, b.x, nloc, nx); b.st[0] = nloc; b.st[1] = nx; }
        const unsigned old = xb_add(&bar[XB_XSUB(b.x)], 1u);
        const unsigned gen = old / nloc;
        if (old + 1u == (gen + 1u) * nloc) {
            __builtin_amdgcn_fence(__ATOMIC_RELEASE, "agent");
            asm volatile("s_waitcnt vmcnt(0)" ::: "memory");
            const unsigned og = xb_add(&bar[XB_TOP], 1u);
            const unsigned tg = og / nx;
            if (og + 1u == (tg + 1u) * nx) xb_add(&bar[XB_TOPGEN], 1u);
            else XB_SPIN(xb_ld(&bar[XB_TOPGEN]) == tg, bar);
            __builtin_amdgcn_fence(__ATOMIC_ACQUIRE, "agent");
            xb_add(&bar[XB_XGEN(b.x)], 1u);
            asm volatile("s_waitcnt vmcnt(0)" ::: "memory");
        } else {
            XB_SPIN(xb_ld(&bar[XB_XGEN(b.x)]) == gen, bar);
            __builtin_amdgcn_fence(__ATOMIC_ACQUIRE, "agent");
            asm volatile("s_waitcnt vmcnt(0)" ::: "memory");
        }
    }
    __syncthreads();
}

struct Args { const float* in[30]; float* out; unsigned char* ws; int s_lo, s_hi; };
struct Frame {
    LAS unsigned char* lds;
    volatile LAS unsigned* MISC;
    unsigned* ctl;
    int tid, lane, wave, vcu, G, bid;
    float* x;
    unsigned char* ws;
};
#define WSP(T, off) ((T*)(F.ws + (off)))
constexpr int TAB_OFF = LDSCTL_OFF + 512;
__device__ __forceinline__ const float* inp(const Frame& F, int k) {
    const volatile LAS unsigned* t = (const volatile LAS unsigned*)(F.lds + TAB_OFF) + 2 * k;
    const unsigned lo = __builtin_amdgcn_readfirstlane(t[0]), hi = __builtin_amdgcn_readfirstlane(t[1]);
    return (const float*)(GAS const float*)(((unsigned long long)hi << 32) | lo);
}

struct TileAddr { const float* src; int ld_src; bf16* dst; int ldd; int goff; };
__device__ __forceinline__ void tr_load(const TileAddr& t, f32x4 (&v)[16], int lane) {
    const int r0 = lane >> 4, c4 = (lane & 15) * 4;
#pragma unroll
    for (int i = 0; i < 16; ++i) v[i] = __builtin_nontemporal_load((const GAS f32x4*)(t.src + (size_t)(4 * i + r0) * t.ld_src + c4));
}
__device__ __forceinline__ void tr_store(const TileAddr& t, const f32x4 (&v)[16], LAS float* scr, const LAS float* gl, int lane) {
    const int r0 = lane >> 4, c4 = (lane & 15) * 4;
#pragma unroll
    for (int i = 0; i < 16; ++i) { const int kk = 4 * i + r0; float gk = 1.0f; if (t.goff >= 0) gk = gl[t.goff + kk];
        scr[(c4 + 0) * 65 + kk] = v[i].x * gk; scr[(c4 + 1) * 65 + kk] = v[i].y * gk; scr[(c4 + 2) * 65 + kk] = v[i].z * gk; scr[(c4 + 3) * 65 + kk] = v[i].w * gk; }
    LDS_WAIT(); asm volatile("" ::: "memory");
    const int kc = lane & 7;
#pragma unroll
    for (int p = 0; p < 8; ++p) { const int n = (lane >> 3) + 8 * p; const LAS float* tt = scr + n * 65 + 8 * kc;
        v4u o; o.x = pk2(tt[0], tt[1]); o.y = pk2(tt[2], tt[3]); o.z = pk2(tt[4], tt[5]); o.w = pk2(tt[6], tt[7]);
        *(v4u*)(t.dst + (size_t)n * t.ldd + 8 * kc) = o; }
    LDS_WAIT(); asm volatile("" ::: "memory");
}
__device__ __forceinline__ void rms_row_bf16(const float* xrow, const float* g, bf16* orow, float* copy_to, int lane) {
    const f32x4* xr = (const f32x4*)xrow + lane;
    f32x4 v[4]; float s = 0.f;
    f32x4 gq[4];
#pragma unroll
    for (int j = 0; j < 4; ++j) { v[j] = ((const GAS f32x4*)xr)[64 * j]; gq[j] = ((const GAS f32x4*)g)[lane + 64 * j]; }
    __builtin_amdgcn_sched_barrier(0);
#pragma unroll
    for (int j = 0; j < 4; ++j) s += (v[j].x * v[j].x + v[j].y * v[j].y) + (v[j].z * v[j].z + v[j].w * v[j].w);
    const float rstd = 1.0f / sqrtf(wave_sum(s, lane) * (1.f / 1024.f) + 1e-6f);
    unsigned long long* o8 = (unsigned long long*)orow + lane;
#pragma unroll
    for (int j = 0; j < 4; ++j) { const f32x4 gv = gq[j];
        o8[64 * j] = (unsigned long long)pk2(v[j].x * rstd * gv.x, v[j].y * rstd * gv.y) | ((unsigned long long)pk2(v[j].z * rstd * gv.z, v[j].w * rstd * gv.w) << 32);
        if (copy_to) ((f32x4*)copy_to)[lane + 64 * j] = v[j]; }
}

__device__ __forceinline__ void xb_row_load(const float* xrow, f32x4 (&v)[4], int lane) {
    const GAS f32x4* xr = (const GAS f32x4*)xrow + lane;
#pragma unroll
    for (int j = 0; j < 4; ++j) v[j] = xr[64 * j];
}
__device__ __forceinline__ void xb_row_finish(const f32x4 (&v)[4], bf16* orow, float* rstd_out, int lane) {
    float s = 0.f;
#pragma unroll
    for (int j = 0; j < 4; ++j) s += (v[j].x * v[j].x + v[j].y * v[j].y) + (v[j].z * v[j].z + v[j].w * v[j].w);
    const float rstd = 1.0f / sqrtf(wave_sum(s, lane) * (1.f / 1024.f) + 1e-6f);
    if (lane == 0) *rstd_out = rstd;
    GAS unsigned long long* o8 = (GAS unsigned long long*)orow + lane;
#pragma unroll
    for (int j = 0; j < 4; ++j) o8[64 * j] = (unsigned long long)pk2(v[j].x, v[j].y) | ((unsigned long long)pk2(v[j].z, v[j].w) << 32);
}

__device__ __forceinline__ void ph_prep(Frame& F, const Args& A, int lay) {
    const int gw = F.vcu * NWAVES + F.wave, NGW = F.G * NWAVES, lane = F.lane;
    const int parts = 3, vb = F.bid, vG = F.G;
    {
        const float* w_in = inp(F, 3) + (size_t)lay * D * INC;
        const float* w_kv = inp(F, 21);
        const float* w_br = inp(F, 22) + (size_t)lay * 3 * BW * D;
        const float* w_out = inp(F, 23) + (size_t)lay * D * D;
        const float* w1 = inp(F, 26) + (size_t)lay * NE * D * FF;
        const float* w3 = inp(F, 27) + (size_t)lay * NE * D * FF;
        const float* w2 = inp(F, 28) + (size_t)lay * NE * FF * D;
        bf16* WIN = WSP(bf16, WS_WIN); bf16* WKV = WSP(bf16, WS_WKV4); bf16* WBR = WSP(bf16, WS_WBR); bf16* WOUT = WSP(bf16, WS_WOUT);
        bf16* W13 = WSP(bf16, WS_W13); bf16* W2 = WSP(bf16, WS_W2);
        constexpr int T_IN = 16 * 96, T_BR = 3 * 8 * 16, T_OUT = 16 * 16, T_E = NE * 16 * 16, T_KV = DEPTH * 16 * 16;
        const int NTILES = (parts & 2) ? T_IN + T_BR + T_OUT + 3 * T_E + (lay == 0 ? T_KV : 0) : T_IN + T_BR + T_OUT;
        const int TLO = (parts & 1) ? 0 : T_IN + T_BR + T_OUT;
        LAS float* scr64 = (LAS float*)(F.lds + F.wave * 16640);
        LAS float* gl = (LAS float*)(F.lds + 8 * 16640);
        { const float* g1 = inp(F, 2) + (size_t)lay * D; const float* g2 = inp(F, 24) + (size_t)lay * D;
          __syncthreads();
          { const float a0 = ((const GAS float*)g1)[F.tid], a1 = ((const GAS float*)g1)[F.tid + NTHR], b0 = ((const GAS float*)g2)[F.tid], b1 = ((const GAS float*)g2)[F.tid + NTHR];
            gl[F.tid] = a0; gl[F.tid + NTHR] = a1; gl[D + F.tid] = b0; gl[D + F.tid + NTHR] = b1; }
          __syncthreads(); }
#define TR_DECODE(it_, T_) do { int r = (it_); \
            if (r < T_IN) { const int kb = r / 96, nb = r % 96; T_.src = w_in + (size_t)(64 * kb) * INC + 64 * nb; T_.ld_src = INC; T_.dst = WIN + (size_t)(64 * nb) * 1024 + 64 * kb; T_.ldd = 1024; T_.goff = 64 * kb; break; } r -= T_IN; \
            T_.goff = -1; if (r < T_BR) { const int n = r / 128, r2 = r % 128, kb = r2 / 16, nb = r2 % 16; T_.src = w_br + (size_t)n * BW * D + (size_t)(64 * kb) * D + 64 * nb; T_.ld_src = D; T_.dst = WBR + (size_t)(n * 1024 + 64 * nb) * BW + 64 * kb; T_.ldd = BW; break; } r -= T_BR; \
            if (r < T_OUT) { const int kb = r / 16, nb = r % 16; T_.src = w_out + (size_t)(64 * kb) * D + 64 * nb; T_.ld_src = D; T_.dst = WOUT + (size_t)(64 * nb) * D + 64 * kb; T_.ldd = D; break; } r -= T_OUT; \
            if (r < 2 * T_E) { const int which = r / T_E, r1 = r % T_E, e = r1 / 256, r2 = r1 % 256, kb = r2 / 16, nb = r2 % 16, f0 = 64 * nb; \
                T_.src = (which ? w3 : w1) + (size_t)e * D * FF + (size_t)(64 * kb) * FF + f0; T_.ld_src = FF; \
                T_.dst = W13 + (size_t)(e * 2048 + (f0 >> 7) * 256 + (f0 & 127) + which * 128) * D + 64 * kb; T_.ldd = D; T_.goff = 1024 + 64 * kb; break; } r -= 2 * T_E; \
            if (r < T_E) { const int e = r / 256, r2 = r % 256, kb = r2 / 16, nb = r2 % 16; T_.src = w2 + (size_t)e * FF * D + (size_t)(64 * kb) * D + 64 * nb; T_.ld_src = D; T_.dst = W2 + (size_t)(e * 1024 + 64 * nb) * FF + 64 * kb; T_.ldd = FF; break; } r -= T_E; \
            { const int lk = r / 256, r2 = r % 256, kb = r2 / 16, nb = r2 % 16; T_.src = w_kv + (size_t)lk * D * 1024 + (size_t)(64 * kb) * 1024 + 64 * nb; T_.ld_src = 1024; T_.dst = WKV + (size_t)(lk * 1024 + 64 * nb) * D + 64 * kb; T_.ldd = D; } } while (0)
        int it = TLO + gw; TileAddr tc; f32x4 vc[16];
        if (it < NTILES) { TR_DECODE(it, tc); tr_load(tc, vc, lane); }
        while (it < NTILES) { const int nx = it + NGW; const bool hn = nx < NTILES; TileAddr tn = tc; f32x4 vn[16];
            if (hn) { TR_DECODE(nx, tn); tr_load(tn, vn, lane); }
            tr_store(tc, vc, scr64, gl, lane);
            if (hn) { tc = tn;
#pragma unroll
                for (int i = 0; i < 16; ++i) vc[i] = vn[i]; }
            it = nx; }
#undef TR_DECODE
    }
    if (parts & 1) {
    {
        const float* sw = inp(F, 7) + (size_t)lay * 4 * 128 * 128; bf16* WSB = WSP(bf16, WS_WSB);
        for (int i = vb * NTHR + F.tid; i < 4 * 128 * 128 / 8; i += vG * NTHR) { const f32x4 a = ((const f32x4*)sw)[2 * i], b = ((const f32x4*)sw)[2 * i + 1];
            v4u o; o.x = pk2(a.x, a.y); o.y = pk2(a.z, a.w); o.z = pk2(b.x, b.y); o.w = pk2(b.z, b.w); ((v4u*)WSB)[i] = o; }
    }
    {
        if (lay == 0) { bf16* H = WSP(bf16, WS_H); float* RS1 = WSP(float, WS_RSTD1); const float* xs = inp(F, 0);
            f32x4 vc[4], vn[4];
            if (gw < M) xb_row_load(xs + (size_t)gw * D, vc, lane);
            for (int m = gw; m < M; m += NGW) { const bool hn = m + NGW < M;
                if (hn) xb_row_load(xs + (size_t)(m + NGW) * D, vn, lane);
                xb_row_finish(vc, H + (size_t)m * D, RS1 + m, lane);
                if (hn) {
#pragma unroll
                    for (int j = 0; j < 4; ++j) vc[j] = vn[j]; } } }
        if (lay == 0) { bf16* MEMN = WSP(bf16, WS_MEMN4);
            for (int m = gw; m < DEPTH * MM; m += NGW) { const int lk = m / MM, mr = m % MM; rms_row_bf16(inp(F, 1) + (size_t)mr * D, inp(F, 20) + (size_t)lk * D, MEMN + (size_t)m * D, nullptr, lane); } }
    }
    {
        __syncthreads();
        LAS float* zf = (LAS float*)F.lds;
        LAS float* ha = zf + 16 * 36;
        LAS float* hb = ha + 16 * 64;
        LAS float* lw1 = hb + 16 * 64;
        LAS float* lw2 = lw1 + 33 * 64;
        LAS float* lw3 = lw2 + 64 * 64;
        LAS float* lb = lw3 + 64 * 64;
        const float* fw4 = inp(F, 17) + (size_t)lay * 64 * 1024;
        bf16* KRT = WSP(bf16, WS_FILT);
        const int tid = F.tid;
        { const float* fw1 = inp(F, 11) + (size_t)lay * 33 * 64; const float* fw2 = inp(F, 13) + (size_t)lay * 64 * 64; const float* fw3 = inp(F, 15) + (size_t)lay * 64 * 64;
          { float t1[5], t2[8], t3[8];
#pragma unroll
            for (int k = 0; k < 5; ++k) { const int i = tid + NTHR * k; t1[k] = i < 33 * 64 ? ((const GAS float*)fw1)[i] : 0.f; }
#pragma unroll
            for (int k = 0; k < 8; ++k) { t2[k] = ((const GAS float*)fw2)[tid + NTHR * k]; t3[k] = ((const GAS float*)fw3)[tid + NTHR * k]; }
#pragma unroll
            for (int k = 0; k < 5; ++k) { const int i = tid + NTHR * k; if (i < 33 * 64) lw1[i] = t1[k]; }
#pragma unroll
            for (int k = 0; k < 8; ++k) { lw2[tid + NTHR * k] = t2[k]; lw3[tid + NTHR * k] = t3[k]; } }
          if (tid < 64) { const float* p0 = inp(F, 12) + (size_t)lay * 64; const float* p1 = inp(F, 14) + (size_t)lay * 64; const float* p2 = inp(F, 16) + (size_t)lay * 64; const float* p3 = inp(F, 18) + (size_t)lay * 64;
            const float q0 = ((const GAS float*)p0)[tid], q1 = ((const GAS float*)p1)[tid], q2 = ((const GAS float*)p2)[tid], q3 = ((const GAS float*)p3)[tid];
            lb[tid] = q0; lb[64 + tid] = q1; lb[128 + tid] = q2; lb[192 + tid] = q3; } }
        for (int pos0 = vb * 16; pos0 < L; pos0 += vG * 16) {
            __syncthreads();
            for (int idx = tid; idx < 16 * 33; idx += NTHR) { const int p = idx / 33, j = idx % 33, i = pos0 + p; float val;
                if (j == 0) val = (float)i * (1.0f / 4095.0f);
                else { const int jj = (j - 1) & 15; const float fj = 1e-4f + (float)jj * ((15.0f - 1e-4f) / 15.0f); const float turns = fj * (float)i * (1.0f / 4096.0f);
                       val = (j <= 16) ? cos_turns(turns) : -sin_turns(turns); }
                zf[p * 36 + j] = val; }
            __syncthreads();
            for (int idx = tid; idx < 1024; idx += NTHR) { const int p = idx >> 6, o = idx & 63; float a = lb[o];
                for (int j = 0; j < 33; ++j) a += zf[p * 36 + j] * lw1[j * 64 + o];
                ha[p * 64 + o] = sin_rad(lb[192 + o] * a); }
            __syncthreads();
            for (int idx = tid; idx < 1024; idx += NTHR) { const int p = idx >> 6, o = idx & 63; float a = lb[64 + o];
                for (int j = 0; j < 64; ++j) a += ha[p * 64 + j] * lw2[j * 64 + o];
                hb[p * 64 + o] = sin_rad(lb[192 + o] * a); }
            __syncthreads();
            for (int idx = tid; idx < 1024; idx += NTHR) { const int p = idx >> 6, o = idx & 63; float a = lb[128 + o];
                for (int j = 0; j < 64; ++j) a += hb[p * 64 + j] * lw3[j * 64 + o];
                ha[p * 64 + o] = sin_rad(lb[192 + o] * a); }
            __syncthreads();
            float a0[16], a1[16];
#pragma unroll
            for (int p = 0; p < 16; ++p) { a0[p] = 0.f; a1[p] = 0.f; }
#pragma unroll 1
            for (int ob = 0; ob < 64; ob += 16) { float w0[16], w1v[16];
#pragma unroll
                for (int oo = 0; oo < 16; ++oo) { w0[oo] = fw4[(ob + oo) * 1024 + tid]; w1v[oo] = fw4[(ob + oo) * 1024 + 512 + tid]; }
#pragma unroll
                for (int oo = 0; oo < 16; ++oo)
#pragma unroll
                    for (int p = 0; p < 16; ++p) { const float h = ha[p * 64 + ob + oo]; a0[p] += h * w0[oo]; a1[p] += h * w1v[oo]; } }
            const float min_decay = -3.0701134573253945f, max_decay = -15.350567286626973f;
            const float delta = fabsf(min_decay + (float)tid * ((max_decay - min_decay) / 511.0f));
#pragma unroll
            for (int p = 0; p < 16; ++p) { const float t = (float)(pos0 + p) * (1.0f / 4095.0f); const float dec = __expf(-t * delta); a0[p] *= dec; a1[p] *= dec; }
            bf16* kr = KRT + (size_t)tid * 8192;
            {
                v4u w0, w1;
                w0.x = pk2(a0[15], a0[14]); w0.y = pk2(a0[13], a0[12]); w0.z = pk2(a0[11], a0[10]); w0.w = pk2(a0[9], a0[8]);
                w1.x = pk2(a0[7], a0[6]); w1.y = pk2(a0[5], a0[4]); w1.z = pk2(a0[3], a0[2]); w1.w = pk2(a0[1], a0[0]);
                *(v4u*)(kr + 4080 - pos0) = w0; *(v4u*)(kr + 4088 - pos0) = w1; }
#pragma unroll
            for (int p = 0; p < 16; ++p) { if (pos0 + p > 0) kr[4095 + pos0 + p] = (bf16)f2bf(a1[p]); }
            if (pos0 == L - 16) kr[8191] = 0;
        }
        __syncthreads();
    }
    }
}

__device__ __forceinline__ int xcd_remap(int L_, int nwg) { const int q = nwg / 8, r = nwg % 8, xcd = L_ % 8, off = L_ / 8; return (xcd < r ? xcd * (q + 1) : r * (q + 1) + (xcd - r) * q) + off; }
struct BranchOrder {
    int G, c; pg8::StaticOrder so;
    __device__ __forceinline__ void init(int G_, int c_) { G = G_; c = c_; so.init(M, D, 1, 0); }
    __device__ __forceinline__ bool next(int i, pg8::Unit& u) const {
        const int ti = (i / 3) * G + c, nb = i % 3; if (ti >= 512) return false;
        pg8::Unit t; pg8::StaticOrder s2 = so; s2.G = 1; s2.c = ti; s2.next(0, t);
        u.pm = nb * 128 + t.pm; u.pn = nb * 4 + t.pn; return true; }
    __device__ __forceinline__ void a_ready(const pg8::Unit&) const {}
    __device__ __forceinline__ void done(const pg8::Unit&) const {}
};
struct WinOrder {
    pg8::StaticOrder so;
    __device__ __forceinline__ void init(int G_, int c_) { so.init(M, INC - 1536, G_, c_); }
    __device__ __forceinline__ bool next(int i, pg8::Unit& u) const { if (!so.next(i, u)) return false; if (u.pn >= 4) u.pn += 6; return true; }
    __device__ __forceinline__ void a_ready(const pg8::Unit&) const {}
    __device__ __forceinline__ void done(const pg8::Unit&) const {}
};
struct MoeOrder {
    int G, c, npn;
    __device__ __forceinline__ void init(int G_, int c_, int npn_) { G = G_; c = c_; npn = npn_; }
    __device__ __forceinline__ bool next(int i, pg8::Unit& u) const {
        const int nwg = NE * 16 * npn; const int L_ = i * G + c; if (L_ >= nwg) return false;
        const int w = xcd_remap(L_, nwg); const int per = 16 * npn; const int e = w / per, r = w % per;
        u.pm = e * 16 + r / npn; u.pn = e * npn + r % npn; return true; }
    __device__ __forceinline__ void a_ready(const pg8::Unit&) const {}
    __device__ __forceinline__ void done(const pg8::Unit&) const {}
};

struct EpiKv {
    static constexpr bool PERM = true, AFTER_DRAIN = false;
    bf16* O;
    __device__ __forceinline__ void operator()(const pg8::f32x4 (&acc)[2][2][4][2], const pg8::Unit& u, int wr, int wc, int fr, int fq) const {
        const int row0 = u.pm * 256 + wr * 64 + fr, col0 = (u.pn & 3) * 256 + wc * 32 + 8 * fq;
#pragma unroll
        for (int ai = 0; ai < 2; ++ai)
#pragma unroll
            for (int m = 0; m < 4; ++m) { bf16* rowp = O + (size_t)(row0 + ai * 128 + m * 16) * 1024 + col0;
#pragma unroll
                for (int bj = 0; bj < 2; ++bj) { const pg8::f32x4 v0 = acc[ai][bj][m][0], v1 = acc[ai][bj][m][1];
                    pg8::u32x4 w; w.x = pg8::cvt_pk_bf16(v0[0], v0[1]); w.y = pg8::cvt_pk_bf16(v0[2], v0[3]); w.z = pg8::cvt_pk_bf16(v1[0], v1[1]); w.w = pg8::cvt_pk_bf16(v1[2], v1[3]);
                    *(GAS pg8::u32x4*)(rowp + bj * 128) = w; } }
    }
};
__device__ __forceinline__ unsigned pk4_u8(float a, float b, float c, float d) {
    unsigned w = 0u; w = __builtin_amdgcn_cvt_pk_u8_f32(fmaxf(__builtin_rintf(a * 255.0f), 1.0f), 0, w); w = __builtin_amdgcn_cvt_pk_u8_f32(fmaxf(__builtin_rintf(b * 255.0f), 1.0f), 1, w);
    w = __builtin_amdgcn_cvt_pk_u8_f32(fmaxf(__builtin_rintf(c * 255.0f), 1.0f), 2, w); w = __builtin_amdgcn_cvt_pk_u8_f32(fmaxf(__builtin_rintf(d * 255.0f), 1.0f), 3, w); return w; }
struct EpiCols {
    static constexpr bool PERM = true, AFTER_DRAIN = false;
    bf16 *UV, *P, *Q, *G; const LAS float* gate_b; const float* RS;
    __device__ __forceinline__ void prefetch(const pg8::Unit& u, int wr, int wc, int fr, int fq, float (&pre)[8]) const { const int row0 = u.pm * 256 + wr * 64 + fr;
#pragma unroll
        for (int ai = 0; ai < 2; ++ai)
#pragma unroll
            for (int m = 0; m < 4; ++m) pre[ai * 4 + m] = ((const GAS float*)RS)[row0 + ai * 128 + m * 16]; }
    __device__ __forceinline__ void operator()(const pg8::f32x4 (&acc)[2][2][4][2], const pg8::Unit& u, int wr, int wc, int fr, int fq, const float (&pre)[8]) const {
        const int row0 = u.pm * 256 + wr * 64 + fr; const int pn = u.pn;
        bf16* base; int ldc, colt, mode;
        if (pn < 4) { base = UV; ldc = 1024; colt = pn * 256; mode = 1; }
        else if (pn < 10) { base = P; ldc = 1536; colt = (pn - 4) * 256; mode = 0; }
        else if (pn < 12) { base = Q; ldc = 512; colt = (pn - 10) * 256; mode = 0; }
        else { base = G; ldc = 3072; colt = (pn - 12) * 256; mode = 2; }
        const int col0 = colt + wc * 32 + 8 * fq;
        pg8::f32x4 bv[2][2];
#pragma unroll
        for (int bj = 0; bj < 2; ++bj)
#pragma unroll
            for (int n = 0; n < 2; ++n) bv[bj][n] = (mode == 2) ? *(const LAS pg8::f32x4*)(gate_b + col0 + bj * 128 + 4 * n) : (pg8::f32x4){0.f, 0.f, 0.f, 0.f};
#pragma unroll
        for (int ai = 0; ai < 2; ++ai) { v2u ge[2] = {{0u, 0u}, {0u, 0u}};
#pragma unroll
            for (int m = 0; m < 4; ++m) { bf16* rowp = base + (size_t)(row0 + ai * 128 + m * 16) * ldc + col0; const float rs = pre[ai * 4 + m];
#pragma unroll
                for (int bj = 0; bj < 2; ++bj) { pg8::f32x4 v0 = acc[ai][bj][m][0] * rs + bv[bj][0], v1 = acc[ai][bj][m][1] * rs + bv[bj][1];
                    if (mode == 1) { pg8::f32x2 a = pg8::gelu_pk((pg8::f32x2){v0[0], v0[1]}), b = pg8::gelu_pk((pg8::f32x2){v0[2], v0[3]}), c = pg8::gelu_pk((pg8::f32x2){v1[0], v1[1]}), d = pg8::gelu_pk((pg8::f32x2){v1[2], v1[3]});
                        v0 = (pg8::f32x4){a.x, a.y, b.x, b.y}; v1 = (pg8::f32x4){c.x, c.y, d.x, d.y}; }
                    else if (mode == 2) {
#pragma unroll
                        for (int j = 0; j < 4; ++j) { v0[j] = sigmoidf_(v0[j]); v1[j] = sigmoidf_(v1[j]); } }
                    if (mode == 2) { v2u w8; w8.x = pk4_u8(v0[0], v0[1], v0[2], v0[3]); w8.y = pk4_u8(v1[0], v1[1], v1[2], v1[3]);
                        if ((m & 1) == 0) ge[bj] = w8;
                        else { auto s0_ = __builtin_amdgcn_permlane16_swap(ge[bj].x, w8.x, false, false); auto s1_ = __builtin_amdgcn_permlane16_swap(ge[bj].y, w8.y, false, false);
                            const v4u w16 = {s0_[0], s1_[0], s0_[1], s1_[1]};
                            *(GAS v4u*)((unsigned char*)G + (size_t)(row0 + ai * 128 + (m - 1 + (fq & 1)) * 16) * 3072 + (col0 - 8 * (fq & 1)) + bj * 128) = w16; } }
                    else { pg8::u32x4 w; w.x = pg8::cvt_pk_bf16(v0[0], v0[1]); w.y = pg8::cvt_pk_bf16(v0[2], v0[3]); w.z = pg8::cvt_pk_bf16(v1[0], v1[1]); w.w = pg8::cvt_pk_bf16(v1[2], v1[3]);
                        *(GAS pg8::u32x4*)(rowp + bj * 128) = w; } } } }
    }
};
struct EpiPT {
    static constexpr bool PERM = true, AFTER_DRAIN = false; static constexpr int NPRE = 16;
    bf16* PT; const float* RS;
    __device__ __forceinline__ void prefetch(const pg8::Unit& u, int wr, int wc, int fr, int fq, float (&pre)[16]) const { const int tok0 = u.pn * 256 + wc * 32 + 8 * fq;
#pragma unroll
        for (int bj = 0; bj < 2; ++bj)
#pragma unroll
            for (int n = 0; n < 2; ++n) { const pg8::f32x4 r = *(const GAS pg8::f32x4*)(RS + tok0 + bj * 128 + 4 * n); pre[bj * 8 + n * 4 + 0] = r[0]; pre[bj * 8 + n * 4 + 1] = r[1]; pre[bj * 8 + n * 4 + 2] = r[2]; pre[bj * 8 + n * 4 + 3] = r[3]; } }
    __device__ __forceinline__ void operator()(const pg8::f32x4 (&acc)[2][2][4][2], const pg8::Unit& u, int wr, int wc, int fr, int fq, const float (&pre)[16]) const {
        const int ch0 = u.pm * 256 + wr * 64 + fr, tok0 = u.pn * 256 + wc * 32 + 8 * fq;
#pragma unroll
        for (int ai = 0; ai < 2; ++ai)
#pragma unroll
            for (int m = 0; m < 4; ++m) { bf16* rowp = PT + (size_t)(ch0 + ai * 128 + m * 16) * PTS + tok0;
#pragma unroll
                for (int bj = 0; bj < 2; ++bj) { const pg8::f32x4 v0 = acc[ai][bj][m][0], v1 = acc[ai][bj][m][1];
                    pg8::u32x4 w; w.x = pg8::cvt_pk_bf16(v0[0] * pre[bj * 8 + 0], v0[1] * pre[bj * 8 + 1]); w.y = pg8::cvt_pk_bf16(v0[2] * pre[bj * 8 + 2], v0[3] * pre[bj * 8 + 3]);
                    w.z = pg8::cvt_pk_bf16(v1[0] * pre[bj * 8 + 4], v1[1] * pre[bj * 8 + 5]); w.w = pg8::cvt_pk_bf16(v1[2] * pre[bj * 8 + 6], v1[3] * pre[bj * 8 + 7]);
                    *(GAS pg8::u32x4*)(rowp + bj * 128) = w; } }
    }
};
constexpr int PAN_WINP = (int)((WS_WIN + (size_t)1024 * D * 2) / (512 * 1024)), PAN_XB = (int)(WS_H / (512 * 1024)), PAN_MEMN = (int)(WS_MEMN4 / (512 * 1024)), PAN_WKV = (int)(WS_WKV4 / (512 * 1024));
static_assert((WS_WIN + (size_t)1024 * D * 2) % (512 * 1024) == 0 && WS_H % (512 * 1024) == 0 && WS_MEMN4 % (512 * 1024) == 0 && WS_WKV4 % (512 * 1024) == 0, "panel alignment");
struct PtKvOrder {
    pg8::StaticOrder so; int G, c, nkv;
    __device__ __forceinline__ void init(int G_, int c_, int nkv_) { so.init(1536, M, G_, c_); G = G_; c = c_; nkv = nkv_; }
    __device__ __forceinline__ bool next(int i, pg8::Unit& u) const {
        if (so.next(i, u)) { u.pm += PAN_WINP; u.pn += PAN_XB; return true; }
        const int L_ = i * G + c - 768; if (L_ < 0 || L_ >= nkv) return false;
        const int lk = L_ >> 5, r = L_ & 31; u.pm = PAN_MEMN + lk * 8 + (r >> 2); u.pn = PAN_WKV + lk * 4 + (r & 3); return true; }
    __device__ __forceinline__ void a_ready(const pg8::Unit&) const {}
    __device__ __forceinline__ void done(const pg8::Unit&) const {}
};
struct EpiPtKv {
    static constexpr bool PERM = true, AFTER_DRAIN = false; static constexpr int NPRE = 16;
    EpiPT pt; EpiKv kv;
    __device__ __forceinline__ void prefetch(const pg8::Unit& u, int wr, int wc, int fr, int fq, float (&pre)[16]) const {
        if (u.pm < PAN_MEMN) { pg8::Unit v; v.pm = u.pm - PAN_WINP; v.pn = u.pn - PAN_XB; pt.prefetch(v, wr, wc, fr, fq, pre); } }
    __device__ __forceinline__ void operator()(const pg8::f32x4 (&acc)[2][2][4][2], const pg8::Unit& u, int wr, int wc, int fr, int fq, const float (&pre)[16]) const {
        if (u.pm < PAN_MEMN) { pg8::Unit v; v.pm = u.pm - PAN_WINP; v.pn = u.pn - PAN_XB; pt(acc, v, wr, wc, fr, fq, pre); }
        else { pg8::Unit v; v.pm = u.pm - PAN_MEMN; v.pn = u.pn - PAN_WKV; kv(acc, v, wr, wc, fr, fq); } }
};
struct EpiBranch {
    static constexpr bool PERM = true, AFTER_DRAIN = false;
    const unsigned char* G; bf16* MERGED;
    __device__ __forceinline__ bool carry(const pg8::Unit& u) const { return (u.pm >> 7) < 2; }
    __device__ __forceinline__ void operator()(pg8::f32x4 (&acc)[2][2][4][2], const pg8::Unit& u, int wr, int wc, int fr, int fq) const {
        const int nb = u.pm >> 7, pm = u.pm & 127, pn = u.pn & 3;
        const int row0 = pm * 256 + wr * 64 + fr, col0 = pn * 256 + wc * 32 + 8 * fq;
        const unsigned char* Ga = G + (size_t)row0 * 3072 + nb * 1024 + col0; const unsigned char* Gb = Ga + (nb < 2 ? 1024 : 0);
        int fp = fq & 1; asm volatile("" : "+v"(fp));
        const unsigned char* Ga2 = Ga + (size_t)(fp * 16) * 3072 - 8 * fp; const unsigned char* Gb2 = Gb + (size_t)(fp * 16) * 3072 - 8 * fp;
        v4u la[2][2][2], lb[2][2][2];
#pragma unroll
        for (int ai = 0; ai < 2; ++ai)
#pragma unroll
            for (int k = 0; k < 2; ++k)
#pragma unroll
                for (int bj = 0; bj < 2; ++bj) { const size_t o = (size_t)(ai * 128 + 2 * k * 16) * 3072 + bj * 128; la[ai][k][bj] = *(const GAS v4u*)(Ga2 + o); lb[ai][k][bj] = (v4u){0u, 0u, 0u, 0u}; if (nb < 2) lb[ai][k][bj] = *(const GAS v4u*)(Gb2 + o); }
        asm volatile("" ::: "memory");
#pragma unroll
        for (int ai = 0; ai < 2; ++ai)
#pragma unroll
            for (int k = 0; k < 2; ++k)
#pragma unroll
                for (int bj = 0; bj < 2; ++bj) { const v4u a = la[ai][k][bj], b = lb[ai][k][bj];
                    auto a0_ = __builtin_amdgcn_permlane16_swap(a.x, a.z, false, false); auto a1_ = __builtin_amdgcn_permlane16_swap(a.y, a.w, false, false);
                    auto b0_ = __builtin_amdgcn_permlane16_swap(b.x, b.z, false, false); auto b1_ = __builtin_amdgcn_permlane16_swap(b.y, b.w, false, false);
                    la[ai][k][bj] = (v4u){a0_[0], a1_[0], a0_[1], a1_[1]}; lb[ai][k][bj] = (v4u){b0_[0], b1_[0], b0_[1], b1_[1]}; }
#pragma unroll
        for (int ai = 0; ai < 2; ++ai) {
#pragma unroll
            for (int m = 0; m < 4; ++m) { const size_t row = (size_t)(row0 + ai * 128 + m * 16);
#pragma unroll
                for (int bj = 0; bj < 2; ++bj) { const int col = col0 + bj * 128;
                    const v4u A4 = la[ai][m >> 1][bj], B4 = lb[ai][m >> 1][bj]; const v2u a = (m & 1) ? (v2u){A4.z, A4.w} : (v2u){A4.x, A4.y}, b = (m & 1) ? (v2u){B4.z, B4.w} : (v2u){B4.x, B4.y};
                    float f[8] = {(float)(a.x & 255u), (float)((a.x >> 8) & 255u), (float)((a.x >> 16) & 255u), (float)(a.x >> 24), (float)(a.y & 255u), (float)((a.y >> 8) & 255u), (float)((a.y >> 16) & 255u), (float)(a.y >> 24)};
                    if (nb < 2) { const float d[8] = {(float)(b.x & 255u), (float)((b.x >> 8) & 255u), (float)((b.x >> 16) & 255u), (float)(b.x >> 24), (float)(b.y & 255u), (float)((b.y >> 8) & 255u), (float)((b.y >> 16) & 255u), (float)(b.y >> 24)};
#pragma unroll
                        for (int k = 0; k < 8; ++k) f[k] *= __builtin_amdgcn_rcpf(fmaxf(d[k], 1.0f)); }
                    else {
#pragma unroll
                        for (int k = 0; k < 8; ++k) f[k] *= (1.0f / 255.0f); }
                    pg8::f32x4 v0 = acc[ai][bj][m][0], v1 = acc[ai][bj][m][1];
                    v0[0] *= f[0]; v0[1] *= f[1]; v0[2] *= f[2]; v0[3] *= f[3]; v1[0] *= f[4]; v1[1] *= f[5]; v1[2] *= f[6]; v1[3] *= f[7];
                    if (nb < 2) { acc[ai][bj][m][0] = v0; acc[ai][bj][m][1] = v1; }
                    else { pg8::u32x4 w; w.x = pg8::cvt_pk_bf16(v0[0], v0[1]); w.y = pg8::cvt_pk_bf16(v0[2], v0[3]); w.z = pg8::cvt_pk_bf16(v1[0], v1[1]); w.w = pg8::cvt_pk_bf16(v1[2], v1[3]);
                        *(GAS pg8::u32x4*)(MERGED + row * 1024 + col) = w; } } } }
    }
};
struct EpiResNorm {
    static constexpr bool PERM = true, AFTER_DRAIN = false;
    bf16* XB; float* PSS;
    __device__ __forceinline__ void operator()(const pg8::f32x4 (&acc)[2][2][4][2], const pg8::Unit& u, int wr, int wc, int fr, int fq) const {
        const int row0 = u.pm * 256 + wr * 64 + fr, col0 = u.pn * 256 + wc * 32 + 8 * fq, lane4 = (fq * 16 + fr) << 2;
        pg8::u32x4 xo[2][4][2];
#pragma unroll
        for (int ai = 0; ai < 2; ++ai)
#pragma unroll
            for (int m = 0; m < 4; ++m)
#pragma unroll
                for (int bj = 0; bj < 2; ++bj) xo[ai][m][bj] = *(const GAS pg8::u32x4*)(XB + (size_t)(row0 + ai * 128 + m * 16) * D + col0 + bj * 128);
        asm volatile("" ::: "memory");
#pragma unroll
        for (int ai = 0; ai < 2; ++ai) {
#pragma unroll
            for (int m = 0; m < 4; ++m) { const size_t row = (size_t)(row0 + ai * 128 + m * 16); float ss = 0.f;
#pragma unroll
                for (int bj = 0; bj < 2; ++bj) { const pg8::u32x4 o = xo[ai][m][bj]; const pg8::f32x4 a = acc[ai][bj][m][0], b = acc[ai][bj][m][1];
                    pg8::u32x4 w; w.x = pg8::cvt_pk_bf16(bflo(o.x) + a[0], bfhi(o.x) + a[1]); w.y = pg8::cvt_pk_bf16(bflo(o.y) + a[2], bfhi(o.y) + a[3]);
                    w.z = pg8::cvt_pk_bf16(bflo(o.z) + b[0], bfhi(o.z) + b[1]); w.w = pg8::cvt_pk_bf16(bflo(o.w) + b[2], bfhi(o.w) + b[3]);
                    *(GAS pg8::u32x4*)(XB + row * D + col0 + bj * 128) = w;
                    ss += ((bflo(w.x) * bflo(w.x) + bfhi(w.x) * bfhi(w.x)) + (bflo(w.y) * bflo(w.y) + bfhi(w.y) * bfhi(w.y))) + ((bflo(w.z) * bflo(w.z) + bfhi(w.z) * bfhi(w.z)) + (bflo(w.w) * bflo(w.w) + bfhi(w.w) * bfhi(w.w))); }
                ss += __builtin_bit_cast(float, __builtin_amdgcn_ds_bpermute(lane4 ^ 64, __builtin_bit_cast(int, ss)));
                ss += __builtin_bit_cast(float, __builtin_amdgcn_ds_bpermute(lane4 ^ 128, __builtin_bit_cast(int, ss)));
                if (fq == 0) ((GAS float*)PSS)[row * 16 + (u.pn & 3) * 4 + wc] = ss; } }
    }
};
struct EpiMoeUp {
    static constexpr bool PERM = true, AFTER_DRAIN = false;
    bf16* HID; const float* RSG;
    __device__ __forceinline__ void prefetch(const pg8::Unit& u, int wr, int wc, int fr, int fq, float (&pre)[8]) const { const int row0 = u.pm * 256 + wr * 64 + fr;
#pragma unroll
        for (int ai = 0; ai < 2; ++ai)
#pragma unroll
            for (int m = 0; m < 4; ++m) pre[ai * 4 + m] = ((const GAS float*)RSG)[row0 + ai * 128 + m * 16]; }
    __device__ __forceinline__ void operator()(const pg8::f32x4 (&acc)[2][2][4][2], const pg8::Unit& u, int wr, int wc, int fr, int fq, const float (&pre)[8]) const {
        const int row0 = u.pm * 256 + wr * 64 + fr, col0 = (u.pn & 7) * 128 + wc * 32 + 8 * fq;
#pragma unroll
        for (int ai = 0; ai < 2; ++ai)
#pragma unroll
            for (int m = 0; m < 4; ++m) { bf16* rowp = HID + (size_t)(row0 + ai * 128 + m * 16) * FF + col0; const float rs = pre[ai * 4 + m];
                pg8::f32x4 h0, h1;
#pragma unroll
                for (int j = 0; j < 4; ++j) { const float a = acc[ai][0][m][0][j] * rs, b = acc[ai][0][m][1][j] * rs;
                    h0[j] = a * sigmoidf_(a) * (acc[ai][1][m][0][j] * rs); h1[j] = b * sigmoidf_(b) * (acc[ai][1][m][1][j] * rs); }
                pg8::u32x4 w; w.x = pg8::cvt_pk_bf16(h0[0], h0[1]); w.y = pg8::cvt_pk_bf16(h0[2], h0[3]); w.z = pg8::cvt_pk_bf16(h1[0], h1[1]); w.w = pg8::cvt_pk_bf16(h1[2], h1[3]);
                *(GAS pg8::u32x4*)rowp = w; }
    }
};
struct EpiMoeDown {
    static constexpr bool PERM = true, AFTER_DRAIN = false;
    bf16* Y; const float* GATE;
    __device__ __forceinline__ void prefetch(const pg8::Unit& u, int wr, int wc, int fr, int fq, float (&pre)[8]) const { const int e = u.pm >> 4; const int rl0 = (u.pm & 15) * 256 + wr * 64 + fr;
#pragma unroll
        for (int ai = 0; ai < 2; ++ai)
#pragma unroll
            for (int m = 0; m < 4; ++m) { const int rl = rl0 + ai * 128 + m * 16; pre[ai * 4 + m] = ((const GAS float*)GATE)[((rl >> 9) * NE + e) * CAP + (rl & 511)]; } }
    __device__ __forceinline__ void operator()(const pg8::f32x4 (&acc)[2][2][4][2], const pg8::Unit& u, int wr, int wc, int fr, int fq, const float (&pre)[8]) const {
        const int e = u.pm >> 4; const int rl0 = (u.pm & 15) * 256 + wr * 64 + fr, col0 = (u.pn & 3) * 256 + wc * 32 + 8 * fq;
#pragma unroll
        for (int ai = 0; ai < 2; ++ai)
#pragma unroll
            for (int m = 0; m < 4; ++m) { const int rl = rl0 + ai * 128 + m * 16; const float gt = pre[ai * 4 + m];
                bf16* rowp = Y + (size_t)(e * 4096 + rl) * D + col0;
#pragma unroll
                for (int bj = 0; bj < 2; ++bj) { const pg8::f32x4 v0 = acc[ai][bj][m][0] * gt, v1 = acc[ai][bj][m][1] * gt;
                    pg8::u32x4 w; w.x = pg8::cvt_pk_bf16(v0[0], v0[1]); w.y = pg8::cvt_pk_bf16(v0[2], v0[3]); w.z = pg8::cvt_pk_bf16(v1[0], v1[1]); w.w = pg8::cvt_pk_bf16(v1[2], v1[3]);
                    *(GAS pg8::u32x4*)(rowp + bj * 128) = w; } }
    }
};

__device__ __forceinline__ void unpack8(const v4u w, float (&x)[8]) { x[0] = bflo(w.x); x[1] = bfhi(w.x); x[2] = bflo(w.y); x[3] = bfhi(w.y); x[4] = bflo(w.z); x[5] = bfhi(w.z); x[6] = bflo(w.w); x[7] = bfhi(w.w); }
__device__ __forceinline__ void load8bf(const bf16* p, float (&x)[8]) {
    const v4u w = *(const v4u*)p;
    x[0] = bflo(w.x); x[1] = bfhi(w.x); x[2] = bflo(w.y); x[3] = bfhi(w.y); x[4] = bflo(w.z); x[5] = bfhi(w.z); x[6] = bflo(w.w); x[7] = bfhi(w.w);
}
constexpr int SG_ROW = 272, SG_ST = 512 * SG_ROW + 64 * 16;
#define SG_AT(c_) ((c_) * SG_ROW + ((c_) >> 3) * 16)
static_assert(SG_ST <= LDSCTL_OFF, "sgu LDS map");
__device__ __forceinline__ void ph_sgu(Frame& F, const Args& A, int lay) {
    typedef float f32x16 __attribute__((ext_vector_type(16)));
    typedef short s16x8 __attribute__((ext_vector_type(8)));
    const bf16* UV = WSP(bf16, WS_UV); bf16* BR0 = WSP(bf16, WS_BR); const bf16* WSB = WSP(bf16, WS_WSB);
    const float* lng = inp(F, 5) + (size_t)lay * BW; const float* lnb = inp(F, 6) + (size_t)lay * BW; const float* sb = inp(F, 8) + (size_t)lay * 4 * 128;
    LAS unsigned char* lds = F.lds;
    const int lane = F.lane, wave = F.wave;
    float gk[8], bk[8];
    { const f32x4 g0 = *(const f32x4*)(lng + 8 * lane), g1 = *(const f32x4*)(lng + 8 * lane + 4), b0 = *(const f32x4*)(lnb + 8 * lane), b1 = *(const f32x4*)(lnb + 8 * lane + 4);
      gk[0] = g0.x; gk[1] = g0.y; gk[2] = g0.z; gk[3] = g0.w; gk[4] = g1.x; gk[5] = g1.y; gk[6] = g1.z; gk[7] = g1.w;
      bk[0] = b0.x; bk[1] = b0.y; bk[2] = b0.z; bk[3] = b0.w; bk[4] = b1.x; bk[5] = b1.y; bk[6] = b1.z; bk[7] = b1.w; }
    const int g = wave >> 1, ph = wave & 1, pl = lane & 31, hh = lane >> 5;
    for (int blk = F.bid; blk < M / 128; blk += F.G) {
        const int row0 = blk * 128;
        v4u vraw[16];
#pragma unroll
        for (int rr = 0; rr < 16; ++rr) vraw[rr] = *(const v4u*)(UV + (size_t)(row0 + 16 * wave + rr) * 1024 + 512 + 8 * lane);
        s16x8 Bf[2][8];
#pragma unroll
        for (int pt = 0; pt < 2; ++pt)
#pragma unroll
            for (int ks = 0; ks < 8; ++ks) Bf[pt][ks] = *(const s16x8*)(WSB + ((size_t)(g * 128 + 64 * ph + 32 * pt + pl) * 128 + 16 * ks + 8 * hh));
        __syncthreads();
#pragma unroll
        for (int q4 = 0; q4 < 4; ++q4) { const int q0 = 16 * wave + 4 * q4;
            float x[4][8], mean[4], rstd[4];
#pragma unroll
            for (int rr = 0; rr < 4; ++rr) unpack8(vraw[4 * q4 + rr], x[rr]);
#pragma unroll
            for (int rr = 0; rr < 4; ++rr) { float s = 0.f;
#pragma unroll
                for (int k = 0; k < 8; ++k) s += x[rr][k];
                mean[rr] = wave_sum(s, lane) * (1.f / 512.f); }
#pragma unroll
            for (int rr = 0; rr < 4; ++rr) { float q = 0.f;
#pragma unroll
                for (int k = 0; k < 8; ++k) { const float d = x[rr][k] - mean[rr]; q += d * d; }
                rstd[rr] = 1.0f / sqrtf(wave_sum(q, lane) * (1.f / 512.f) + 1e-5f); }
#pragma unroll
            for (int k = 0; k < 8; ++k) { float y[4];
#pragma unroll
                for (int rr = 0; rr < 4; ++rr) y[rr] = (x[rr][k] - mean[rr]) * rstd[rr] * gk[k] + bk[k];
                v2u o; o.x = pk2(y[0], y[1]); o.y = pk2(y[2], y[3]);
                *(LAS v2u*)(lds + SG_AT(8 * lane + k) + q0 * 2) = o; } }
        __syncthreads();
        float sbv[2];
#pragma unroll
        for (int pt = 0; pt < 2; ++pt) sbv[pt] = ((const GAS float*)sb)[g * 128 + 64 * ph + 32 * pt + pl];
#pragma unroll 1
        for (int ct = 0; ct < 4; ++ct) {
            const size_t rowA = (size_t)(row0 + 64 * ph + pl); const int cb = g * 128 + 32 * ct + 4 * hh;
            v2u uu[2][4];
#pragma unroll
            for (int pt = 0; pt < 2; ++pt)
#pragma unroll
                for (int j = 0; j < 4; ++j) uu[pt][j] = *(const GAS v2u*)(UV + (rowA + 32 * pt) * 1024 + cb + 8 * j);
            f32x16 C0, C1;
#pragma unroll
            for (int k = 0; k < 16; ++k) { C0[k] = 0.f; C1[k] = 0.f; }
            const LAS unsigned char* bp = lds + SG_AT(g * 128 + 32 * ct + pl) + 16 * hh;
#pragma unroll
            for (int ks = 0; ks < 8; ++ks) { const s16x8 Vf = *(const LAS s16x8*)(bp + 32 * ks);
                C0 = __builtin_amdgcn_mfma_f32_32x32x16_bf16(Vf, Bf[0][ks], C0, 0, 0, 0); C1 = __builtin_amdgcn_mfma_f32_32x32x16_bf16(Vf, Bf[1][ks], C1, 0, 0, 0); }
#pragma unroll
            for (int pt = 0; pt < 2; ++pt) { v2u oq[4];
#pragma unroll
                for (int j = 0; j < 4; ++j) { const v2u uq = uu[pt][j]; const float sbp = sbv[pt];
                    const float c0 = (pt == 0 ? C0[4 * j] : C1[4 * j]) + sbp, c1 = (pt == 0 ? C0[4 * j + 1] : C1[4 * j + 1]) + sbp, c2 = (pt == 0 ? C0[4 * j + 2] : C1[4 * j + 2]) + sbp, c3 = (pt == 0 ? C0[4 * j + 3] : C1[4 * j + 3]) + sbp;
                    oq[j].x = pk2(bflo(uq.x) * c0, bfhi(uq.x) * c1); oq[j].y = pk2(bflo(uq.y) * c2, bfhi(uq.y) * c3); }
#pragma unroll
                for (int q = 0; q < 2; ++q) {
                    auto s0_ = __builtin_amdgcn_permlane32_swap(oq[2 * q].x, oq[2 * q + 1].x, false, false); auto s1_ = __builtin_amdgcn_permlane32_swap(oq[2 * q].y, oq[2 * q + 1].y, false, false);
                    const v4u w_ = {s0_[0], s1_[0], s0_[1], s1_[1]};
                    *(GAS v4u*)(BR0 + (rowA + 32 * pt) * BW + (g * 128 + 32 * ct + 8 * hh) + 16 * q) = w_; } }
        }
    }
    __syncthreads();
}

__device__ __forceinline__ void shortconv8(const bf16* P, size_t row, int t, int col, const float* cw, const float* cb, float (&o)[8]) {
    float a[8], b[8], c[8];
    load8bf(P + row * 1536 + col, b);
    if (t > 0) load8bf(P + (row - 1) * 1536 + col, a); else {
#pragma unroll
        for (int k = 0; k < 8; ++k) a[k] = 0.f; }
    if (t < L - 1) load8bf(P + (row + 1) * 1536 + col, c); else {
#pragma unroll
        for (int k = 0; k < 8; ++k) c[k] = 0.f; }
#pragma unroll
    for (int k = 0; k < 8; ++k) o[k] = cw[col + k] * a[k] + cw[1536 + col + k] * b[k] + cw[3072 + col + k] * c[k] + cb[col + k];
}
constexpr int HT_ROW = 272;
#define HT_AT(c_, byte_) ((c_) * HT_ROW + ((c_) >> 3) * 16 + (byte_))
__device__ __forceinline__ void conv8(const v4u p, const unsigned pl, const unsigned pr, const float wa, const float wb, const float wc, const float bias, float (&o)[8]) {
    float x[8]; unpack8(p, x); const float xm = bfhi(pl), xp = bflo(pr);
    o[0] = wa * xm + wb * x[0] + wc * x[1] + bias;
#pragma unroll
    for (int k = 1; k < 7; ++k) o[k] = wa * x[k - 1] + wb * x[k] + wc * x[k + 1] + bias;
    o[7] = wa * x[6] + wb * x[7] + wc * xp + bias;
}
constexpr int HY_RS = 8976, HY_KOFF = 8 * HY_RS, HY_CS = 16448;
static_assert(HY_KOFF + 4 * HY_CS <= LDSCTL_OFF, "hyena LDS map");
__device__ __forceinline__ void ph_hyconv(Frame& F, const Args& A, int lay) {
    typedef float f32x16 __attribute__((ext_vector_type(16)));
    typedef short s16x8 __attribute__((ext_vector_type(8)));
    const bf16* PT = WSP(bf16, WS_PT); const bf16* KRT = WSP(bf16, WS_FILT); bf16* YT = WSP(bf16, WS_YT); const float* hbias = inp(F, 19) + (size_t)lay * BW;
    const float* cw = inp(F, 9) + (size_t)lay * 3 * 1536; const float* cb = inp(F, 10) + (size_t)lay * 1536;
    LAS unsigned char* lds = F.lds;
    const int tid = F.tid, lane = F.lane, w = F.wave;
    const int i = lane & 31, g = lane >> 5, r = (3 - i) & 3;
    const int abase = HY_KOFF + r * HY_CS + 2 * (4095 + 8 * g - i - r) - 1024 * w - 64;
    const int dl = i >> 3, bb = i & 7;
    const int bbase = bb * HY_RS + 128 * dl + 16 * g + 384;
    v4u xq[8], vq[8];
#define HY_PREFETCH(c_) do { const bf16* X1_ = PT + (size_t)(512 + (c_)) * PTS + 8 * tid; _Pragma("unroll") for (int b = 0; b < 8; ++b) xq[b] = __builtin_nontemporal_load((const GAS v4u*)(X1_ + b * L)); } while (0)
#define HY_FETCHV(c_) do { const bf16* VV_ = PT + (size_t)(1024 + (c_)) * PTS + 8 * tid; _Pragma("unroll") for (int b = 0; b < 8; ++b) vq[b] = __builtin_nontemporal_load((const GAS v4u*)(VV_ + b * L)); } while (0)
#pragma unroll
    for (int b = 0; b < 8; ++b) { xq[b] = (v4u){0u, 0u, 0u, 0u}; vq[b] = (v4u){0u, 0u, 0u, 0u}; }
    if (F.bid < BW) HY_PREFETCH(F.bid);
    for (int c = F.bid; c < BW; c += F.G) {
        HY_FETCHV(c);
        __syncthreads();
        if (tid < 384) { const int b = tid / 48, k = tid % 48; const int off = b * HY_RS + (k < 24 ? 16 * k : 8576 + 16 * (k - 24)); unsigned z_ = 0u; asm volatile("" : "+v"(z_)); *(LAS v4u*)(lds + off) = (v4u){z_, z_, z_, z_}; }
        {
            const float xa = cw[512 + c], xb = cw[1536 + 512 + c], xc = cw[3072 + 512 + c], xo = cb[512 + c], va = cw[1024 + c], vb = cw[1536 + 1024 + c], vc = cw[3072 + 1024 + c], vo = cb[1024 + c];
            const int lm = ((lane - 1) & 63) << 2, lp = ((lane + 1) & 63) << 2;
            unsigned ex[8], ev[8];
#pragma unroll
            for (int b = 0; b < 8; ++b) { ex[b] = 0u; ev[b] = 0u; }
            int l_ = lane; asm volatile("" : "+v"(l_));
            if (l_ == 0 || l_ == 63) { const bf16* X1_ = PT + (size_t)(512 + c) * PTS + 8 * (64 * w + l_); const bf16* VV_ = PT + (size_t)(1024 + c) * PTS + 8 * (64 * w + l_); const int eo_ = l_ == 0 ? (w > 0 ? -2 : 0) : (w < 7 ? 8 : 0);
#pragma unroll
                for (int b = 0; b < 8; ++b) { ex[b] = *(const GAS unsigned*)(X1_ + b * L + eo_); ev[b] = *(const GAS unsigned*)(VV_ + b * L + eo_); } }
#pragma unroll
            for (int b = 0; b < 8; ++b) { float x1[8], v1[8];
                unsigned xl = (unsigned)__builtin_amdgcn_ds_bpermute(lm, (int)xq[b].w), xr = (unsigned)__builtin_amdgcn_ds_bpermute(lp, (int)xq[b].x);
                unsigned vl = (unsigned)__builtin_amdgcn_ds_bpermute(lm, (int)vq[b].w), vr = (unsigned)__builtin_amdgcn_ds_bpermute(lp, (int)vq[b].x);
                if (lane == 0) { xl = tid > 0 ? ex[b] : 0u; vl = tid > 0 ? ev[b] : 0u; }
                if (lane == 63) { xr = tid < 511 ? ex[b] : 0u; vr = tid < 511 ? ev[b] : 0u; }
                conv8(xq[b], xl, xr, xa, xb, xc, xo, x1); conv8(vq[b], vl, vr, va, vb, vc, vo, v1);
                v4u o; o.x = pk2(x1[0] * v1[0], x1[1] * v1[1]); o.y = pk2(x1[2] * v1[2], x1[3] * v1[3]); o.z = pk2(x1[4] * v1[4], x1[5] * v1[5]); o.w = pk2(x1[6] * v1[6], x1[7] * v1[7]);
                *(LAS v4u*)(lds + b * HY_RS + 384 + 16 * tid) = o; } }
        const v4u wq[2] = {*(const GAS v4u*)(KRT + (size_t)c * 8192 + 8 * tid), *(const GAS v4u*)(KRT + (size_t)c * 8192 + 8 * (tid + NTHR))};
#pragma unroll
        for (int k2 = 0; k2 < 2; ++k2) { const int k = tid + NTHR * k2; const v4u wv = wq[k2];
            *(LAS v4u*)(lds + HY_KOFF + 16 * k) = wv;
            const unsigned ww[4] = {wv.x, wv.y, wv.z, wv.w};
#pragma unroll
            for (int rr = 1; rr < 4; ++rr)
#pragma unroll
                for (int jj = 0; jj < 8; ++jj) { const int q = 8 * k + jj - rr; const bf16 el = (bf16)((jj & 1) ? (ww[jj >> 1] >> 16) : (ww[jj >> 1] & 0xffffu));
                    if (q >= 0) *(LAS bf16*)(lds + HY_KOFF + rr * HY_CS + 2 * q) = el; } }
        __syncthreads();
        if (c + F.G < BW) HY_PREFETCH(c + F.G);
        f32x16 C00, C01, C10, C11;
#pragma unroll
        for (int k = 0; k < 16; ++k) { C00[k] = 0.f; C01[k] = 0.f; C10[k] = 0.f; C11[k] = 0.f; }
        s16x8 FA[6], FB[6], Q0[4], Q1[4], Q2[4], Q3[4];
#define HY_LD1(dst, ao_, o_) do { const v2u lo_ = *(const LAS v2u*)(lds + (ao_) + 32 * (o_)), hi_ = *(const LAS v2u*)(lds + (ao_) + 32 * (o_) + 8); const v4u q4_ = {lo_.x, lo_.y, hi_.x, hi_.y}; dst = __builtin_bit_cast(s16x8, q4_); } while (0)
#define HY_LD6(FF, S0_) do { int ao_ = abase + 128 * (S0_); asm volatile("" : "+v"(ao_)); _Pragma("unroll") for (int o = 0; o < 6; ++o) HY_LD1(FF[o], ao_, o); } while (0)
#define HY_LD4(FN, FP, S0_) do { int ao_ = abase + 128 * (S0_); asm volatile("" : "+v"(ao_)); FN[0] = FP[4]; FN[1] = FP[5]; _Pragma("unroll") for (int o = 2; o < 6; ++o) HY_LD1(FN[o], ao_, o); } while (0)
#define HY_LDQ(QQ, S0_) do { if ((S0_) <= 59) { const int bo_ = bbase + 128 * (S0_) + 512; _Pragma("unroll") for (int jp = 0; jp < 4; ++jp) QQ[jp] = *(const LAS s16x8*)(lds + bo_ + 32 * jp); } } while (0)
#define HY_MM0(FF, BB, S0_) do { if ((S0_) >= -3) { _Pragma("unroll") for (int jp = 0; jp < 4; ++jp) { C00 = __builtin_amdgcn_mfma_f32_32x32x16_bf16(FF[2 + jp], BB[jp], C00, 0, 0, 0); C01 = __builtin_amdgcn_mfma_f32_32x32x16_bf16(FF[jp], BB[jp], C01, 0, 0, 0); } } } while (0)
#define HY_MM1(FF, BB, S0_) do { if ((S0_) <= 59) { _Pragma("unroll") for (int jp = 0; jp < 4; ++jp) { C10 = __builtin_amdgcn_mfma_f32_32x32x16_bf16(FF[2 + jp], BB[jp], C10, 0, 0, 0); C11 = __builtin_amdgcn_mfma_f32_32x32x16_bf16(FF[jp], BB[jp], C11, 0, 0, 0); } } } while (0)
#define HY_SB() __builtin_amdgcn_sched_barrier(0)
#define HY_STEP(FC, FN, QQ, S0_) do { HY_LD4(FN, FC, (S0_) + 1); HY_SB(); HY_MM0(FC, QQ, S0_); HY_SB(); HY_LDQ(QQ, S0_); HY_SB(); HY_MM1(FC, QQ, S0_); HY_SB(); } while (0)
        HY_LD6(FA, -7);
#pragma unroll 1
        for (int S0 = -7; S0 <= 57; S0 += 4) { HY_STEP(FA, FB, Q0, S0); HY_STEP(FB, FA, Q1, S0 + 1); HY_STEP(FA, FB, Q2, S0 + 2); HY_STEP(FB, FA, Q3, S0 + 3); }
        HY_STEP(FA, FB, Q0, 61); HY_STEP(FB, FA, Q1, 62); HY_MM0(FA, Q2, 63);
#undef HY_LDQ
#undef HY_STEP
#undef HY_PREFETCH
#undef HY_FETCHV
#undef HY_LD1
#undef HY_LD6
#undef HY_LD4
#undef HY_MM0
#undef HY_MM1
#undef HY_SB
        const float hb = hbias[c];
        bf16* yb = YT + ((size_t)c * NB + bb) * L + 512 * w + 64 * dl + 8 * g;
        const LAS unsigned char* urow = lds + bb * HY_RS + 384 + 2 * (512 * w + 64 * dl + 4 * g);
#define HY_ST(CC, tile, ip) do { v2u o_[4]; _Pragma("unroll") for (int r4 = 0; r4 < 4; ++r4) { const v2u u4 = *(const LAS v2u*)(urow + 2 * (256 * (tile) + 32 * (ip) + 8 * r4)); \
            o_[r4].x = pk2(CC[4 * r4] + hb * bflo(u4.x), CC[4 * r4 + 1] + hb * bfhi(u4.x)); o_[r4].y = pk2(CC[4 * r4 + 2] + hb * bflo(u4.y), CC[4 * r4 + 3] + hb * bfhi(u4.y)); } \
            _Pragma("unroll") for (int kk = 0; kk < 2; ++kk) { auto s0_ = __builtin_amdgcn_permlane32_swap(o_[2 * kk].x, o_[2 * kk + 1].x, false, false); auto s1_ = __builtin_amdgcn_permlane32_swap(o_[2 * kk].y, o_[2 * kk + 1].y, false, false); \
                const v4u w_ = {s0_[0], s1_[0], s0_[1], s1_[1]}; *(GAS v4u*)(yb + 256 * (tile) + 32 * (ip) + 16 * kk) = w_; } } while (0)
        HY_ST(C00, 0, 0); HY_ST(C01, 0, 1); HY_ST(C10, 1, 0); HY_ST(C11, 1, 1);
#undef HY_ST
    }
    __syncthreads();
}
__device__ __forceinline__ void ph_hygate(Frame& F, const Args& A, int lay) {
    const bf16* PT = WSP(bf16, WS_PT); const bf16* YT = WSP(bf16, WS_YT); bf16* BR1 = WSP(bf16, WS_BR) + (size_t)M * BW;
    const float* cw = inp(F, 9) + (size_t)lay * 3 * 1536; const float* cb = inp(F, 10) + (size_t)lay * 1536;
    LAS unsigned char* T = F.lds; const int tid = F.tid;
    const int cl = tid >> 3, k16 = tid & 7, tl = tid >> 3, c8 = (tid & 7) * 8;
    v4u yn, pn; unsigned ln, rn; float wn[4];
#define HG_FETCH(tile_) do { const int b_ = (tile_) >> 9, tt_ = ((tile_) >> 3) & 63, c0_ = ((tile_) & 7) * 64, t_ = tt_ * 64 + 8 * k16; \
        const size_t o_ = ((size_t)(c0_ + cl) * NB + b_) * L + t_, q_ = (size_t)(c0_ + cl) * PTS + (size_t)b_ * L + t_; yn = *(const GAS v4u*)(YT + o_); pn = *(const GAS v4u*)(PT + q_); \
        ln = *(const GAS unsigned*)(PT + q_ - (t_ > 0 ? 2 : 0)); rn = *(const GAS unsigned*)(PT + q_ + (t_ < L - 8 ? 8 : 0)); \
        wn[0] = cw[c0_ + cl]; wn[1] = cw[1536 + c0_ + cl]; wn[2] = cw[3072 + c0_ + cl]; wn[3] = cb[c0_ + cl]; } while (0)
    if (F.bid < 4096) HG_FETCH(F.bid);
    for (int tile = F.bid; tile < 4096; tile += F.G) {
        const int b = tile >> 9, tt = (tile >> 3) & 63, cblk = tile & 7, c0 = cblk * 64, t0 = tt * 64;
        const v4u yv = yn, pv = pn; const int tq = t0 + 8 * k16; const unsigned lv = tq > 0 ? ln : 0u, rv = tq < L - 8 ? rn : 0u; const float w0 = wn[0], w1 = wn[1], w2 = wn[2], w3 = wn[3];
        if (tile + F.G < 4096) HG_FETCH(tile + F.G);
        float x0[8], y[8]; conv8(pv, lv, rv, w0, w1, w2, w3, x0); unpack8(yv, y);
        v4u zv; zv.x = pk2(x0[0] * y[0], x0[1] * y[1]); zv.y = pk2(x0[2] * y[2], x0[3] * y[3]); zv.z = pk2(x0[4] * y[4], x0[5] * y[5]); zv.w = pk2(x0[6] * y[6], x0[7] * y[7]);
        __syncthreads();
        *(LAS v4u*)(T + HT_AT(cl, k16 * 16)) = zv;
        __syncthreads();
        unsigned short e[8];
#pragma unroll
        for (int k = 0; k < 8; ++k) e[k] = *(const LAS bf16*)(T + HT_AT(c8 + k, tl * 2));
        v4u wv; wv.x = (unsigned)e[0] | ((unsigned)e[1] << 16); wv.y = (unsigned)e[2] | ((unsigned)e[3] << 16); wv.z = (unsigned)e[4] | ((unsigned)e[5] << 16); wv.w = (unsigned)e[6] | ((unsigned)e[7] << 16);
        *(GAS v4u*)(BR1 + ((size_t)b * L + t0 + tl) * BW + c0 + c8) = wv;
    }
#undef HG_FETCH
    __syncthreads();
}

__device__ __forceinline__ void ph_attn(Frame& F, int lay) {
    const bf16* Q = WSP(bf16, WS_Q); const bf16* KV = WSP(bf16, WS_KV4) + (size_t)lay * MM * 1024; bf16* BR2 = WSP(bf16, WS_BR) + (size_t)2 * M * BW;
    for (int p = F.bid; p < 256; p += F.G) { const int bh = p >> 3, b = bh >> 2, h = bh & 3, qb0 = (p & 7) * 2;
        const bf16* Qb = Q + ((size_t)(b * L + qb0 * 256) * 512 + h * 128); const bf16* Kh = KV + (size_t)(b * MEML) * 1024 + h * 128;
        __syncthreads();
        attn::attn_resident<2>(Qb, Kh, Kh + 512, BR2 + ((size_t)(b * L + qb0 * 256) * 512 + h * 128), (char*)F.lds, F.tid);
    }
    __syncthreads();
}

__device__ __forceinline__ float bperm_f(int srclane, float v) { return __builtin_bit_cast(float, __builtin_amdgcn_ds_bpermute(srclane << 2, __builtin_bit_cast(int, v))); }
__device__ __forceinline__ float reduce16(const float (&lg)[16], int lane) {
    float t8[8], t4[4], t2[2];
    const bool h5 = (lane & 32) != 0, h4 = (lane & 16) != 0, h3 = (lane & 8) != 0, h2 = (lane & 4) != 0;
#pragma unroll
    for (int k = 0; k < 8; ++k) { const float mine = h5 ? lg[8 + k] : lg[k], other = h5 ? lg[k] : lg[8 + k]; t8[k] = mine + bperm_f(lane ^ 32, other); }
#pragma unroll
    for (int k = 0; k < 4; ++k) { const float mine = h4 ? t8[4 + k] : t8[k], other = h4 ? t8[k] : t8[4 + k]; t4[k] = mine + bperm_f(lane ^ 16, other); }
#pragma unroll
    for (int k = 0; k < 2; ++k) { const float mine = h3 ? t4[2 + k] : t4[k], other = h3 ? t4[k] : t4[2 + k]; t2[k] = mine + bperm_f(lane ^ 8, other); }
    float t1; { const float mine = h2 ? t2[1] : t2[0], other = h2 ? t2[0] : t2[1]; t1 = mine + bperm_f(lane ^ 4, other); }
    t1 += bperm_f(lane ^ 2, t1); t1 += bperm_f(lane ^ 1, t1);
    return t1;
}
constexpr int WR_ROW = 2064;
__device__ __forceinline__ void ph_norm2(Frame& F, const Args& A, int lay) {
    typedef short s16x8 __attribute__((ext_vector_type(8)));
    LAS unsigned char* lds = F.lds;
    const float* wrg = inp(F, 25) + (size_t)lay * D * NE; const float* g2 = inp(F, 24) + (size_t)lay * D;
    const bf16* XG = WSP(bf16, WS_H); float* AFF = WSP(float, WS_AFF); float* RS2 = WSP(float, WS_RSTD2); const float* PSS = WSP(float, WS_MSUM);
    const int lane = F.lane;
    const int gw = F.vcu * NWAVES + F.wave, NGW = F.G * NWAVES;
    const int r = lane & 15, kg = lane >> 4;
    int slab = gw; bool have = slab < M / 16;
    s16x8 xa[32]; f32x4 ps = {0.f, 0.f, 0.f, 0.f};
#define N2_LOAD() do { const bf16* xp_ = XG + (size_t)(slab * 16 + r) * D + 8 * kg; _Pragma("unroll") for (int s = 0; s < 32; ++s) xa[s] = *(const GAS s16x8*)(xp_ + 32 * s); \
        ps = *(const GAS f32x4*)(PSS + (size_t)(slab * 16 + r) * 16 + 4 * kg); } while (0)
#pragma unroll
    for (int s = 0; s < 32; ++s) xa[s] = (s16x8){0, 0, 0, 0, 0, 0, 0, 0};
    if (have) N2_LOAD();
    __syncthreads();
#pragma unroll 1
    for (int i0 = F.tid; i0 < D * NE; i0 += 8 * NTHR) { float wv[8], gq[8];
#pragma unroll
        for (int q = 0; q < 8; ++q) { const int i = i0 + NTHR * q; wv[q] = ((const GAS float*)wrg)[i]; gq[q] = ((const GAS float*)g2)[i >> 4]; }
#pragma unroll
        for (int q = 0; q < 8; ++q) { const int i = i0 + NTHR * q, k = i >> 4, e = i & 15; *(LAS bf16*)(lds + e * WR_ROW + 2 * k) = (bf16)f2bf(wv[q] * gq[q]); } }
    __syncthreads();
    const LAS unsigned char* bp = lds + r * WR_ROW + 16 * kg;
    while (have) { const int row0 = slab * 16;
        f32x4 acc = {0.f, 0.f, 0.f, 0.f};
#pragma unroll
        for (int s = 0; s < 32; ++s) { const s16x8 Bf = *(const LAS s16x8*)(bp + 64 * s); acc = __builtin_amdgcn_mfma_f32_16x16x32_bf16(xa[s], Bf, acc, 0, 0, 0); }
        float ss = (ps.x + ps.y) + (ps.z + ps.w);
        ss += bperm_f(lane ^ 16, ss); ss += bperm_f(lane ^ 32, ss);
        const float rstd = 1.0f / sqrtf(ss * (1.f / 1024.f) + 1e-6f);
        if (kg == 0) RS2[row0 + r] = rstd;
        f32x4 pv;
#pragma unroll
        for (int rg = 0; rg < 4; ++rg) {
            const float lg = acc[rg] * bperm_f(4 * kg + rg, rstd);
            float mx = lg;
#pragma unroll
            for (int o = 1; o < 16; o <<= 1) mx = fmaxf(mx, bperm_f(lane ^ o, mx));
            const float ex = __expf(lg - mx); float den = ex;
#pragma unroll
            for (int o = 1; o < 16; o <<= 1) den += bperm_f(lane ^ o, den);
            pv[rg] = ex / den; }
        const int b = row0 >> 12, t0 = (row0 & (L - 1)) + 4 * kg;
        *(GAS f32x4*)(AFF + ((size_t)(b * NE + r)) * L + t0) = pv;
        slab += NGW; have = slab < M / 16;
        if (have) N2_LOAD();
    }
#undef N2_LOAD
    __syncthreads();
}

typedef unsigned long long u64_t;
__device__ __forceinline__ void ph_topk(Frame& F) {
    LAS unsigned* hist = (LAS unsigned*)F.lds;
    LAS unsigned* ctl = hist + 256;
    const float* AFF = WSP(float, WS_AFF); int* IDX = WSP(int, WS_IDX); float* GATE = WSP(float, WS_GATE); int* INV = WSP(int, WS_INV);
    unsigned* RMAP = WSP(unsigned, WS_RMAP); float* RSG = WSP(float, WS_RSG); const float* RS2 = WSP(float, WS_RSTD2);
    const int tid = F.tid, lane = F.lane, wave = F.wave;
    for (int pr = F.bid; pr < NB * NE; pr += F.G) {
        u64_t k8[8];
        { const f32x4 a = ((const f32x4*)(AFF + (size_t)pr * L))[2 * tid], b = ((const f32x4*)(AFF + (size_t)pr * L))[2 * tid + 1];
          const float av[8] = {a.x, a.y, a.z, a.w, b.x, b.y, b.z, b.w};
#pragma unroll
          for (int r = 0; r < 8; ++r) k8[r] = ((u64_t)__builtin_bit_cast(unsigned, av[r]) << 12) | (unsigned)(L - 1 - (8 * tid + r)); }
        u64_t prefix = 0; unsigned need = CAP;
#pragma unroll 1
        for (int pass = 0; pass < 6; ++pass) { const int shift = 40 - 8 * pass;
            __syncthreads();
            if (tid < 256) hist[tid] = 0u;
            __syncthreads();
#pragma unroll
            for (int r = 0; r < 8; ++r) if ((k8[r] >> (shift + 8)) == prefix) __hip_atomic_fetch_add(hist + (unsigned)((k8[r] >> shift) & 255u), 1u, __ATOMIC_RELAXED, __HIP_MEMORY_SCOPE_WORKGROUP);
            __syncthreads();
            if (wave == 0) {
                const unsigned c0 = hist[4 * lane], c1 = hist[4 * lane + 1], c2 = hist[4 * lane + 2], c3 = hist[4 * lane + 3];
                const unsigned sl = c0 + c1 + c2 + c3; unsigned S = sl;
#pragma unroll
                for (int o = 1; o < 64; o <<= 1) { const unsigned t = (unsigned)__builtin_amdgcn_ds_bpermute(((lane + o) & 63) << 2, (int)S); S += (lane + o < 64) ? t : 0u; }
                unsigned above = S - sl;
                if (above < need && need <= above + sl) {
                    int dg; unsigned nd;
                    if (need <= above + c3) { dg = 3; nd = need - above; } else { above += c3;
                    if (need <= above + c2) { dg = 2; nd = need - above; } else { above += c2;
                    if (need <= above + c1) { dg = 1; nd = need - above; } else { above += c1; dg = 0; nd = need - above; } } }
                    ctl[0] = (unsigned)(4 * lane + dg); ctl[1] = nd; }
            }
            __syncthreads();
            prefix = (prefix << 8) | ctl[0]; need = ctl[1];
        }
        unsigned sel = 0u, cnt = 0u;
#pragma unroll
        for (int r = 0; r < 8; ++r) { const bool s1 = k8[r] >= prefix; sel |= (s1 ? 1u : 0u) << r; cnt += s1 ? 1u : 0u; }
        unsigned inc = cnt;
#pragma unroll
        for (int o = 1; o < 64; o <<= 1) { const unsigned t = (unsigned)__builtin_amdgcn_ds_bpermute(((lane - o) & 63) << 2, (int)inc); inc += (lane >= o) ? t : 0u; }
        __syncthreads();
        if (lane == 63) ctl[8 + wave] = inc;
        __syncthreads();
        unsigned base = 0u;
#pragma unroll
        for (int w = 0; w < 8; ++w) base += (w < wave) ? ctl[8 + w] : 0u;
        unsigned pos = base + inc - cnt;
        const int b = pr >> 4, e = pr & 15;
        const f32x4 rq0 = *(const GAS f32x4*)(RS2 + b * L + 8 * tid), rq1 = *(const GAS f32x4*)(RS2 + b * L + 8 * tid + 4); const float rq[8] = {rq0.x, rq0.y, rq0.z, rq0.w, rq1.x, rq1.y, rq1.z, rq1.w};
#pragma unroll
        for (int r = 0; r < 8; ++r) { const int tok = 8 * tid + r; const bool s1 = (sel >> r) & 1u;
            INV[(size_t)pr * L + tok] = s1 ? (int)pos : -1;
            if (s1) { IDX[(size_t)pr * CAP + pos] = tok; GATE[(size_t)pr * CAP + pos] = __builtin_bit_cast(float, (unsigned)(k8[r] >> 12));
                const int grow = (e * NB + b) * CAP + (int)pos;
                RMAP[grow] = (unsigned)(b * L + tok) * (unsigned)(D * 2); RSG[grow] = rq[r]; ++pos; } }
    }
    __syncthreads();
}
__device__ __forceinline__ void ph_combine(Frame& F, const Args& A, int lay) {
    const int* INV = WSP(int, WS_INV); const bf16* Y = WSP(bf16, WS_Y); bf16* XB = WSP(bf16, WS_H); float* RS1 = WSP(float, WS_RSTD1);
    const bool last = (lay + 1 == DEPTH);
    const float* gn = inp(F, 29);
    const int gw = F.vcu * NWAVES + F.wave, NGW = F.G * NWAVES, lane = F.lane;
    LAS unsigned char* stg = F.lds + F.wave * 16384;
    f32x4 gfin[4] = {{0.f, 0.f, 0.f, 0.f}, {0.f, 0.f, 0.f, 0.f}, {0.f, 0.f, 0.f, 0.f}, {0.f, 0.f, 0.f, 0.f}};
    if (last) {
#pragma unroll
        for (int q = 0; q < 4; ++q) gfin[q] = ((const GAS f32x4*)gn)[2 * (lane + 64 * (q >> 1)) + (q & 1)]; }
    int inv_n = -1; v4u vn[4][2];
#define CB_FETCH(M0_) do { const int b_ = (M0_) >> 12, t_ = (M0_) & (L - 1); inv_n = INV[((size_t)(b_ * NE + (lane & 15)) << 12) + t_ + (lane >> 4)]; \
        _Pragma("unroll") for (int rr = 0; rr < 4; ++rr) { const GAS v4u* xr_ = (const GAS v4u*)(XB + (size_t)((M0_) + rr) * D) + lane; _Pragma("unroll") for (int j = 0; j < 2; ++j) vn[rr][j] = xr_[64 * j]; } } while (0)
    if (4 * gw < M) CB_FETCH(4 * gw);
    for (int m0 = 4 * gw; m0 < M; m0 += 4 * NGW) {
        const int b = m0 >> 12;
        const int inv = inv_n;
        f32x4 v[4][4];
#pragma unroll
        for (int rr = 0; rr < 4; ++rr)
#pragma unroll
            for (int j = 0; j < 2; ++j) { const v4u q = vn[rr][j]; v[rr][2 * j] = (f32x4){bflo(q.x), bfhi(q.x), bflo(q.y), bfhi(q.y)}; v[rr][2 * j + 1] = (f32x4){bflo(q.z), bfhi(q.z), bflo(q.w), bfhi(q.w)}; }
        if (m0 + 4 * NGW < M) CB_FETCH(m0 + 4 * NGW);
        unsigned long long mask = __ballot(inv >= 0);
        while (mask) {
            unsigned long long mm = mask;
#pragma unroll 1
            for (int sI = 0; sI < 8 && mm; ++sI) { { const int k = __builtin_ctzll(mm); mm &= mm - 1; const int sl = __builtin_amdgcn_readlane(inv, k); const int e = k & 15;
                const char* yr = (const char*)(Y + (size_t)((e * NB + b) * CAP + sl) * D) + lane * 16;
                __builtin_amdgcn_global_load_lds((const unsigned*)yr, (LAS unsigned*)(stg + sI * 2048), 16, 0, 2);
                __builtin_amdgcn_global_load_lds((const unsigned*)(yr + 1024), (LAS unsigned*)(stg + sI * 2048 + 1024), 16, 0, 2); } }
            asm volatile("s_waitcnt vmcnt(0)" ::: "memory");
            mm = mask;
#pragma unroll 1
            for (int sI = 0; sI < 8 && mm; ++sI) { { const int k = __builtin_ctzll(mm); mm &= mm - 1; const int rr = k >> 4;
                v4u w[2];
#pragma unroll
                for (int j = 0; j < 2; ++j) w[j] = *(const LAS v4u*)(stg + sI * 2048 + 16 * lane + 1024 * j);
#define CB_ADD(RR) do { _Pragma("unroll") for (int j = 0; j < 2; ++j) { v[RR][2 * j].x += bflo(w[j].x); v[RR][2 * j].y += bfhi(w[j].x); v[RR][2 * j].z += bflo(w[j].y); v[RR][2 * j].w += bfhi(w[j].y); \
                    v[RR][2 * j + 1].x += bflo(w[j].z); v[RR][2 * j + 1].y += bfhi(w[j].z); v[RR][2 * j + 1].z += bflo(w[j].w); v[RR][2 * j + 1].w += bfhi(w[j].w); } } while (0)
                if (rr == 0) CB_ADD(0); else if (rr == 1) CB_ADD(1); else if (rr == 2) CB_ADD(2); else CB_ADD(3);
#undef CB_ADD
            } }
            asm volatile("s_waitcnt lgkmcnt(0)" ::: "memory");
            mask = mm;
        }
#pragma unroll
        for (int rr = 0; rr < 4; ++rr) {
            if (last) { float s = 0.f;
#pragma unroll
                for (int q = 0; q < 4; ++q) s += (v[rr][q].x * v[rr][q].x + v[rr][q].y * v[rr][q].y) + (v[rr][q].z * v[rr][q].z + v[rr][q].w * v[rr][q].w);
                const float rstd = 1.0f / sqrtf(wave_sum(s, lane) * (1.f / 1024.f) + 1e-6f);
                GAS f32x4* xr = (GAS f32x4*)(F.x + (size_t)(m0 + rr) * D);
#pragma unroll
                for (int q = 0; q < 4; ++q) { const f32x4 gv = gfin[q]; f32x4 o; o.x = v[rr][q].x * rstd * gv.x; o.y = v[rr][q].y * rstd * gv.y; o.z = v[rr][q].z * rstd * gv.z; o.w = v[rr][q].w * rstd * gv.w;
                    xr[2 * (lane + 64 * (q >> 1)) + (q & 1)] = o; }
            } else { float s = 0.f;
                GAS v4u* o8 = (GAS v4u*)(XB + (size_t)(m0 + rr) * D) + lane;
#pragma unroll
                for (int j = 0; j < 2; ++j) { v4u o; o.x = pk2(v[rr][2 * j].x, v[rr][2 * j].y); o.y = pk2(v[rr][2 * j].z, v[rr][2 * j].w); o.z = pk2(v[rr][2 * j + 1].x, v[rr][2 * j + 1].y); o.w = pk2(v[rr][2 * j + 1].z, v[rr][2 * j + 1].w); o8[64 * j] = o;
                    s += ((bflo(o.x) * bflo(o.x) + bfhi(o.x) * bfhi(o.x)) + (bflo(o.y) * bflo(o.y) + bfhi(o.y) * bfhi(o.y))) + ((bflo(o.z) * bflo(o.z) + bfhi(o.z) * bfhi(o.z)) + (bflo(o.w) * bflo(o.w) + bfhi(o.w) * bfhi(o.w))); }
                const float rstd = 1.0f / sqrtf(wave_sum(s, lane) * (1.f / 1024.f) + 1e-6f);
                if (lane == 0) RS1[m0 + rr] = rstd;
            } }
    }
#undef CB_FETCH
    __syncthreads();
}

__global__ void __launch_bounds__(NTHR, 2) mk_fwd(Args args) {
    extern __shared__ __attribute__((aligned(16))) unsigned char lds[];
    Frame F;
#define FRESH() do { int wv_ = wave0; unsigned m_ = ~0u; asm volatile("" : "+s"(wv_), "+s"(m_)); F.lane = (int)__builtin_amdgcn_mbcnt_hi(m_, __builtin_amdgcn_mbcnt_lo(m_, 0u)); F.wave = wv_; F.tid = wv_ * 64 + F.lane; \
        int g_ = gridDim.x, b_ = blockIdx.x; asm volatile("" : "+s"(g_), "+s"(b_)); F.G = g_; F.bid = b_; F.vcu = (g_ % 8 == 0) ? (b_ % 8) * (g_ / 8) + b_ / 8 : b_; \
        unsigned l_ = 0; asm volatile("" : "+s"(l_)); F.lds = (LAS unsigned char*)lds + l_; F.MISC = (volatile LAS unsigned*)(F.lds + MISC_OFF); \
        unsigned char* w_ = args.ws; asm volatile("" : "+s"(w_)); F.ws = (unsigned char*)(GAS unsigned char*)w_; F.ctl = (unsigned*)(F.ws + WS_CTL); float* x_ = args.out; asm volatile("" : "+s"(x_)); F.x = (float*)(GAS float*)x_; } while (0)
    const int wave0 = __builtin_amdgcn_readfirstlane((int)(threadIdx.x >> 6));
    FRESH();
    for (int u = F.tid; u < (LDS_BYTES - LDSCTL_OFF) / 4; u += NTHR) ((LAS unsigned*)(F.lds + LDSCTL_OFF))[u] = 0u;
    __syncthreads();
    if (F.tid == 0) { LAS unsigned long long* tab = (LAS unsigned long long*)(F.lds + TAB_OFF);
#pragma unroll
        for (int k = 0; k < 30; ++k) tab[k] = (unsigned long long)args.in[k]; }
    __syncthreads();
    XcdBarrier bar; bar.bar = F.ctl + CW_BAR; bar.x = 0; bar.st = nullptr;
    const bool multi = (args.s_hi - args.s_lo) > 1;
    if (multi) bar = xcd_barrier_post(F.ctl + CW_BAR, F.MISC + 8);
    const int s_lo = args.s_lo, s_hi = args.s_hi;
#ifndef PHMASK
#define PHMASK 0xFFFFF
#endif
#define ACTIVE(s) (((PHMASK >> (((s) == DEPTH * NPH) ? 12 : ((s) % NPH))) & 1) && s_lo <= (s) && (s) < s_hi)
#ifndef DUPMASK
#define DUPMASK 0
#endif
#define REP(k) _Pragma("unroll") for (int rep_ = 0; rep_ < (((DUPMASK) >> (k)) & 1) + 1; ++rep_)
#define SEAM(s) do { if ((s) + 1 < s_hi) { XcdBarrier b2_ = bar; asm volatile("" : "+s"(b2_.bar), "+s"(b2_.x)); xcd_barrier(b2_); } } while (0)
    for (int lay = 0; lay < DEPTH; ++lay) {
        const int s0 = lay * NPH;
        if (lay == 0 && ACTIVE(s0 + 0)) { REP(0) { FRESH(); ph_prep(F, args, 0); } SEAM(s0 + 0); }
        if (ACTIVE(s0 + 1)) { REP(1) { FRESH();
            { pg8::Gemm g{WSP(bf16, WS_H), WSP(bf16, WS_WIN), M, INC, D}; WinOrder S; S.init(F.G, F.bid);
              LAS float* gbl = (LAS float*)(F.lds + ROWTAB_OFF);
              { const float* gb = inp(F, 4) + (size_t)lay * 3 * D; __syncthreads();
                float q[6];
#pragma unroll
                for (int k = 0; k < 6; ++k) q[k] = ((const GAS float*)gb)[F.tid + NTHR * k];
#pragma unroll
                for (int k = 0; k < 6; ++k) gbl[F.tid + NTHR * k] = q[k];
                __syncthreads(); }
              EpiCols E{WSP(bf16, WS_UV), WSP(bf16, WS_P), WSP(bf16, WS_Q), WSP(bf16, WS_G), gbl, WSP(float, WS_RSTD1)};
              pg8::gemm_phase<EpiCols, WinOrder, true, true>(F.lds, g, S, E, F.tid); }
            FRESH();
            { pg8::Gemm g{WSP(bf16, 0), WSP(bf16, 0), 0, 0, D}; PtKvOrder S; S.init(F.G, F.bid, lay == 0 ? DEPTH * 32 : 0);
              EpiPtKv E{EpiPT{WSP(bf16, WS_PT), WSP(float, WS_RSTD1)}, EpiKv{WSP(bf16, WS_KV4)}};
              pg8::gemm_phase<EpiPtKv, PtKvOrder, true, true>(F.lds, g, S, E, F.tid); }
            } SEAM(s0 + 1); }
#if MK_SINGLE
        if (ACTIVE(s0 + 2)) {
#pragma unroll 1
            for (int st = 0; st < 2; ++st) { FRESH(); const bool conv = (st == 0) == ((F.bid & 1) != 0);
                if (conv) { REP(3) { FRESH(); ph_hyconv(F, args, lay); } }
                else { REP(13) { FRESH(); ph_sgu(F, args, lay); } REP(15) { FRESH(); ph_attn(F, lay); } } }
            SEAM(s0 + 3); }
#else
        if (ACTIVE(s0 + 2)) { REP(2) { REP(13) { FRESH(); ph_sgu(F, args, lay); } REP(15) { FRESH(); ph_attn(F, lay); } } SEAM(s0 + 2); }
        if (ACTIVE(s0 + 3)) { REP(3) { FRESH(); ph_hyconv(F, args, lay); } SEAM(s0 + 3); }
#endif
        if (ACTIVE(s0 + 4)) { REP(4) { FRESH(); ph_hygate(F, args, lay); } SEAM(s0 + 4); }
        if (ACTIVE(s0 + 5)) { REP(5) { FRESH();
            pg8::Gemm g{WSP(bf16, WS_BR), WSP(bf16, WS_WBR), 3 * M, 3 * D, BW}; BranchOrder S; S.init(F.G, F.bid);
            EpiBranch E{WSP(unsigned char, WS_G), WSP(bf16, WS_MERGED)};
            pg8::gemm_phase<EpiBranch, BranchOrder, true, true>(F.lds, g, S, E, F.tid);
            } SEAM(s0 + 5); }
        if (ACTIVE(s0 + 6)) { REP(6) { FRESH();
            pg8::Gemm g{WSP(bf16, WS_MERGED), WSP(bf16, WS_WOUT), M, D, D}; pg8::StaticOrder S; S.init(M, D, F.G, F.bid);
            EpiResNorm E{WSP(bf16, WS_H), WSP(float, WS_MSUM)};
            pg8::gemm_phase<EpiResNorm, pg8::StaticOrder, true, true>(F.lds, g, S, E, F.tid);
            } SEAM(s0 + 6); }
        if (ACTIVE(s0 + 7)) { REP(7) { FRESH(); ph_norm2(F, args, lay); } SEAM(s0 + 7); }
        if (ACTIVE(s0 + 8)) { REP(8) { FRESH(); ph_topk(F); }
            SEAM(s0 + 8); }
        if (ACTIVE(s0 + 9)) { REP(9) { FRESH();
            pg8::Gemm g{WSP(bf16, WS_H), WSP(bf16, WS_W13), NE * 4096, NE * 2048, D}; MoeOrder S; S.init(F.G, F.bid, 8);
            EpiMoeUp E{WSP(bf16, WS_HID), WSP(float, WS_RSG)};
            { const unsigned* RMAP = WSP(unsigned, WS_RMAP); LAS unsigned* rt = (LAS unsigned*)(F.lds + ROWTAB_OFF);
              __syncthreads();
              unsigned rq[7];
#pragma unroll
              for (int j = 0; j < 7; ++j) { const int ui = 2 * j + (F.wave >> 2); pg8::Unit u; rq[j] = S.next(ui, u) ? ((const GAS unsigned*)RMAP)[u.pm * 256 + (F.tid & 255)] : 0u; }
#pragma unroll
              for (int j = 0; j < 7; ++j) { const int ui = 2 * j + (F.wave >> 2); rt[ui * 256 + (F.tid & 255)] = rq[j]; }
              __syncthreads(); }
            pg8::gemm_phase<EpiMoeUp, MoeOrder, true, true, true>(F.lds, g, S, E, F.tid, (const LAS unsigned*)(F.lds + ROWTAB_OFF));
            } SEAM(s0 + 9); }
        if (ACTIVE(s0 + 10)) { REP(10) { FRESH();
            pg8::Gemm g{WSP(bf16, WS_HID), WSP(bf16, WS_W2), NE * 4096, NE * 1024, FF}; MoeOrder S; S.init(F.G, F.bid, 4);
            EpiMoeDown E{WSP(bf16, WS_Y), WSP(float, WS_GATE)};
            pg8::gemm_phase<EpiMoeDown, MoeOrder, true, true>(F.lds, g, S, E, F.tid);
            } SEAM(s0 + 10); }
        if (ACTIVE(s0 + 11)) { { FRESH(); ph_combine(F, args, lay); } if (lay + 1 < DEPTH) { REP(12) { FRESH(); ph_prep(F, args, lay + 1); } } SEAM(s0 + 11); }
    }
#undef ACTIVE
#undef SEAM
}

extern "C" void kernel_launch(void* const* d_in, const int* in_sizes, int n_in, void* d_out, int out_size, void* d_ws, size_t ws_size, hipStream_t stream) {
    static int grid = 0;
    if (grid == 0) {
        if (n_in != 30 || out_size != M * D || ws_size < WS_END) { fprintf(stderr, "kernel_launch: unexpected shapes: n_in %d out %d ws %zu (need >= %zu)\n", n_in, out_size, ws_size, (size_t)WS_END); grid = -1; return; }
        int dev = 0, cus = 0;
        if (hipGetDevice(&dev) != hipSuccess || hipDeviceGetAttribute(&cus, hipDeviceAttributeMultiprocessorCount, dev) != hipSuccess) { grid = -1; return; }
        if (hipFuncSetAttribute((const void*)mk_fwd, hipFuncAttributeMaxDynamicSharedMemorySize, LDS_BYTES) != hipSuccess) { fprintf(stderr, "kernel_launch: hipFuncSetAttribute failed\n"); grid = -1; return; }
        int per_cu = 0;
        if (hipOccupancyMaxActiveBlocksPerMultiprocessor(&per_cu, (const void*)mk_fwd, NTHR, LDS_BYTES) != hipSuccess || per_cu < 1) fprintf(stderr, "kernel_launch: occupancy query reports %d\n", per_cu);
        (void)hipGetLastError();
        grid = cus;
    }
    if (grid < 0) return;
    (void)hipMemsetAsync((char*)d_ws + WS_CTL, 0, CTL_ZERO_BYTES, stream);
    Args a{};
    for (int i = 0; i < 30; ++i) a.in[i] = (const float*)d_in[i];
    a.out = (float*)d_out; a.ws = (unsigned char*)d_ws;
#if MK_SINGLE
    a.s_lo = 0; a.s_hi = NSTEP;
    hipLaunchKernelGGL(mk_fwd, dim3(grid), dim3(NTHR), LDS_BYTES, stream, a);
#else
    for (int s = 0; s < NSTEP; ++s) {
        a.s_lo = s; a.s_hi = s + 1;
        hipLaunchKernelGGL(mk_fwd, dim3(grid), dim3(NTHR), LDS_BYTES, stream, a);
    }
#endif
    const hipError_t le = hipPeekAtLastError();
    if (le != hipSuccess) fprintf(stderr, "kernel_launch: launch failed: %s\n", hipGetErrorName(le));
}
```
